# Optimizing an MI355X kernel written in HIP

```python
import math
import jax, jax.numpy as jnp
from jax import lax
import numpy as np

D_MODEL = 1024
BATCH = 4
SEQ = 8192
DEPTH = 2

CTX_LEN = 256
GRID_W = 64
HEAD_DIM = 64
LRU_WIDTH = 512
LRU_BLOCKS = 8
LRU_BLOCK = LRU_WIDTH // LRU_BLOCKS
CONV_W = 4
CONV_LEFT = 2
LRU_C = 8.0
GQA_HEADS = 8
GQA_KV_HEADS = 2
GQA_GROUP = GQA_HEADS // GQA_KV_HEADS
DIFF_HEADS = 4
DIFF_V_DIM = 2 * HEAD_DIM
BRANCH_W = 512
N_BRANCH = 3
D_FF = 4 * D_MODEL
Q_BLOCK = 128
ROPE_THETA = 10000.0
EPS = 1e-6
IN_SECTIONS = (LRU_WIDTH, LRU_WIDTH, GQA_HEADS * HEAD_DIM, GQA_KV_HEADS * HEAD_DIM, GQA_KV_HEADS * HEAD_DIM, DIFF_HEADS * 2 * HEAD_DIM, DIFF_HEADS * 2 * HEAD_DIM, DIFF_HEADS * DIFF_V_DIM, N_BRANCH * D_MODEL)
N_IN = 2 * LRU_WIDTH + (GQA_HEADS + 2 * GQA_KV_HEADS) * HEAD_DIM + DIFF_HEADS * (4 * HEAD_DIM + DIFF_V_DIM) + N_BRANCH * D_MODEL

kernel_name = 'hybrid_dit_rglru_gqa_diffattn'


def split_cols(z):
    idx, acc = [], 0
    for w in IN_SECTIONS[:-1]:
        acc += w
        idx.append(acc)
    return jnp.split(z, idx, axis=-1)


def rmsnorm(x, g):
    xf = x.astype(jnp.float32)
    y = xf * lax.rsqrt(jnp.mean(xf * xf, axis=-1, keepdims=True) + EPS)
    return (y * g.astype(jnp.float32)).astype(x.dtype)


def axial_rope_tables(rows):
    row = jnp.broadcast_to(jnp.arange(rows, dtype=jnp.float32)[:, None], (rows, GRID_W)).reshape(-1)
    col = jnp.broadcast_to(jnp.arange(GRID_W, dtype=jnp.float32)[None, :], (rows, GRID_W)).reshape(-1)
    n_freq = HEAD_DIM // 4
    inv = ROPE_THETA ** (-jnp.arange(n_freq, dtype=jnp.float32) * 2.0 / (HEAD_DIM // 2))
    ang = jnp.concatenate([row[:, None] * inv, col[:, None] * inv], axis=-1)
    return jnp.cos(ang), jnp.sin(ang)


def apply_axial_rope(x, cos, sin):
    n_freq = HEAD_DIM // 4
    xs = x.reshape(x.shape[:-1] + (2, 2, n_freq))
    x1 = xs[..., 0, :]
    x2 = xs[..., 1, :]
    cs = cos.reshape(cos.shape[0], 1, 2, n_freq).astype(x.dtype)
    sn = sin.reshape(sin.shape[0], 1, 2, n_freq).astype(x.dtype)
    out = jnp.stack([x1 * cs - x2 * sn, x1 * sn + x2 * cs], axis=-2)
    return out.reshape(x.shape)


def centred_dwconv(u, w, bias):
    t = u.shape[1]
    up = jnp.pad(u, ((0, 0), (CONV_LEFT, CONV_W - 1 - CONV_LEFT), (0, 0)))
    y = up[:, 0:t] * w[0]
    for j in range(1, CONV_W):
        y = y + up[:, j:j + t] * w[j]
    return y + bias


def block_diag_linear(u, w, bias):
    us = u.reshape(u.shape[:-1] + (LRU_BLOCKS, LRU_BLOCK))
    return jnp.einsum('btnc,ncd->btnd', us, w).reshape(u.shape) + bias


def rglru_coeffs(u, w_a, b_a, w_x, b_x, lam):
    uf = u.astype(jnp.float32)
    r = jax.nn.sigmoid(block_diag_linear(uf, w_a.astype(jnp.float32), b_a.astype(jnp.float32)))
    i = jax.nn.sigmoid(block_diag_linear(uf, w_x.astype(jnp.float32), b_x.astype(jnp.float32)))
    log_a = -LRU_C * r * jax.nn.softplus(-lam.astype(jnp.float32))
    a = jnp.exp(log_a)
    b = jnp.sqrt(-jnp.expm1(2.0 * log_a)) * (i * uf)
    return a, b


def _scan_combine(left, right):
    a_l, b_l = left
    a_r, b_r = right
    return a_l * a_r, a_r * b_l + b_r


def linear_scan(a, b, h0, reverse):
    if reverse:
        a = jnp.flip(a, axis=1)
        b = jnp.flip(b, axis=1)
    b = b.at[:, 0].add(a[:, 0] * h0)
    _, h = lax.associative_scan(_scan_combine, (a, b), axis=1)
    if reverse:
        h = jnp.flip(h, axis=1)
    return h


def gqa_attend(q, k, v):
    s = jnp.einsum('bqgrd,bkgd->bgrqk', q, k).astype(jnp.float32) * (HEAD_DIM ** -0.5)
    p = jax.nn.softmax(s, axis=-1).astype(v.dtype)
    return jnp.einsum('bgrqk,bkgd->bqgrd', p, v)


def diff_attend(q1, q2, k1, k2, v, lam):
    scale = HEAD_DIM ** -0.5
    p1 = jax.nn.softmax(jnp.einsum('bqhd,bkhd->bhqk', q1, k1).astype(jnp.float32) * scale, axis=-1)
    p2 = jax.nn.softmax(jnp.einsum('bqhd,bkhd->bhqk', q2, k2).astype(jnp.float32) * scale, axis=-1)
    p = (p1 - lam * p2).astype(v.dtype)
    return jnp.einsum('bhqk,bkhd->bqhd', p, v)


def blocked_queries(fn, qs):
    bsz, t = qs[0].shape[:2]
    nb = t // Q_BLOCK
    blocks = tuple(jnp.moveaxis(a.reshape((bsz, nb, Q_BLOCK) + a.shape[2:]), 1, 0) for a in qs)
    out = lax.map(lambda blk: fn(*blk), blocks)
    out = jnp.moveaxis(out, 0, 1)
    return out.reshape((bsz, t) + out.shape[3:])


def sq_relu_mlp(h, w_up, w_down):
    return jnp.square(jax.nn.relu(h @ w_up)) @ w_down


def token_mixer(hl, hc, p, lam_init, cos, sin, ctx_out):
    bsz, s, _ = hl.shape
    n_ctx = hc.shape[1]
    zl = split_cols(hl @ p['w_in'])
    zc = split_cols(hc @ p['w_in'])

    def heads(z, n):
        return z.reshape(z.shape[:2] + (n, HEAD_DIM))

    ul = centred_dwconv(zl[0], p['conv_w'], p['conv_b'])
    uc = centred_dwconv(zc[0], p['conv_w'], p['conv_b'])
    hs_l, hs_c = [], []
    for d, rev in ((0, False), (1, True)):
        gp = (p['w_rg'][d], p['b_rg'][d], p['w_ig'][d], p['b_ig'][d], p['lru_lambda'][d])
        a_c, b_c = rglru_coeffs(uc, *gp)
        h_c = linear_scan(a_c, b_c, jnp.zeros((bsz, LRU_WIDTH), jnp.float32), rev)
        h0 = h_c[:, 0] if rev else h_c[:, -1]
        a_l, b_l = rglru_coeffs(ul, *gp)
        hs_l.append(linear_scan(a_l, b_l, h0, rev))
        hs_c.append(h_c)
    y_rec_l = ((hs_l[0] + hs_l[1]) * jax.nn.gelu(zl[1].astype(jnp.float32))).astype(hl.dtype)

    ql = apply_axial_rope(rmsnorm(heads(zl[2], GQA_HEADS), p['q_norm_g']), cos, sin)
    kl = apply_axial_rope(rmsnorm(heads(zl[3], GQA_KV_HEADS), p['k_norm_g']), cos, sin)
    vl = heads(zl[4], GQA_KV_HEADS)
    qc = rmsnorm(heads(zc[2], GQA_HEADS), p['q_norm_g'])
    kc = rmsnorm(heads(zc[3], GQA_KV_HEADS), p['k_norm_g'])
    vc = heads(zc[4], GQA_KV_HEADS)
    k_all = jnp.concatenate([kc, kl], axis=1)
    v_all = jnp.concatenate([vc, vl], axis=1)

    def gqa_block(qb):
        qg = qb.reshape(qb.shape[:2] + (GQA_KV_HEADS, GQA_GROUP, HEAD_DIM))
        return gqa_attend(qg, k_all, v_all)

    y_gqa_l = blocked_queries(gqa_block, (ql,)).reshape(bsz, s, GQA_HEADS * HEAD_DIM)

    lam = (jnp.exp(jnp.sum(p['lambda_q1'].astype(jnp.float32) * p['lambda_k1'].astype(jnp.float32)))
           - jnp.exp(jnp.sum(p['lambda_q2'].astype(jnp.float32) * p['lambda_k2'].astype(jnp.float32)))
           + lam_init)
    dql = apply_axial_rope(heads(zl[5], 2 * DIFF_HEADS), cos, sin).reshape(bsz, s, DIFF_HEADS, 2, HEAD_DIM)
    dkl = apply_axial_rope(heads(zl[6], 2 * DIFF_HEADS), cos, sin).reshape(bsz, s, DIFF_HEADS, 2, HEAD_DIM)
    dvl = zl[7].reshape(bsz, s, DIFF_HEADS, DIFF_V_DIM)
    dqc = zc[5].reshape(bsz, n_ctx, DIFF_HEADS, 2, HEAD_DIM)
    dkc = zc[6].reshape(bsz, n_ctx, DIFF_HEADS, 2, HEAD_DIM)
    dvc = zc[7].reshape(bsz, n_ctx, DIFF_HEADS, DIFF_V_DIM)
    dk_all = jnp.concatenate([dkc, dkl], axis=1)
    k1_all = dk_all[:, :, :, 0]
    k2_all = dk_all[:, :, :, 1]
    dv_all = jnp.concatenate([dvc, dvl], axis=1)

    def diff_block(q1b, q2b):
        return diff_attend(q1b, q2b, k1_all, k2_all, dv_all, lam)

    o_l = blocked_queries(diff_block, (dql[:, :, :, 0], dql[:, :, :, 1]))
    y_diff_l = (rmsnorm(o_l, p['subln_g']) * (1.0 - lam_init)).reshape(bsz, s, DIFF_HEADS * DIFF_V_DIM)

    def merge(ys, zg):
        g = jax.nn.sigmoid(zg + p['b_gate']).reshape(zg.shape[:2] + (N_BRANCH, D_MODEL))
        m = g[:, :, 0] * (ys[0] @ p['w_branch'][0])
        for n in range(1, N_BRANCH):
            m = m + g[:, :, n] * (ys[n] @ p['w_branch'][n])
        return m @ p['w_out']

    out_l = merge((y_rec_l, y_gqa_l, y_diff_l), zl[8])
    if not ctx_out:
        return out_l, None

    y_rec_c = ((hs_c[0] + hs_c[1]) * jax.nn.gelu(zc[1].astype(jnp.float32))).astype(hc.dtype)
    qcg = qc.reshape(bsz, n_ctx, GQA_KV_HEADS, GQA_GROUP, HEAD_DIM)
    y_gqa_c = gqa_attend(qcg, kc, vc).reshape(bsz, n_ctx, GQA_HEADS * HEAD_DIM)
    o_c = diff_attend(dqc[:, :, :, 0], dqc[:, :, :, 1], dkc[:, :, :, 0], dkc[:, :, :, 1], dvc, lam)
    y_diff_c = (rmsnorm(o_c, p['subln_g']) * (1.0 - lam_init)).reshape(bsz, n_ctx, DIFF_HEADS * DIFF_V_DIM)
    out_c = merge((y_rec_c, y_gqa_c, y_diff_c), zc[8])
    return out_l, out_c


def setup_inputs(seed: int = 0) -> dict:
    key = jax.random.key(seed)
    ks = jax.random.split(key, 32)
    f32 = jnp.float32

    def nrm(k, shape, scale):
        return jax.random.normal(k, shape, f32) * scale

    u = jax.random.uniform(ks[15], (DEPTH, 2, LRU_WIDTH), f32, 0.9, 0.999)
    a = u ** (1.0 / LRU_C)
    lru_lambda = jnp.log(a) - jnp.log1p(-a)
    return {
        'x': nrm(ks[0], (BATCH, SEQ, D_MODEL), 1.0),
        'c': nrm(ks[1], (BATCH, D_MODEL), 1.0),
        'ctx': nrm(ks[2], (BATCH, CTX_LEN, D_MODEL), 1.0),
        'c_ctx': nrm(ks[3], (D_MODEL,), 1.0),
        'w_mod': nrm(ks[4], (DEPTH, D_MODEL, 6 * D_MODEL), 0.5 * D_MODEL ** -0.5),
        'b_mod': nrm(ks[5], (DEPTH, 6 * D_MODEL), 0.02),
        'norm1_g': 1.0 + nrm(ks[6], (DEPTH, D_MODEL), 0.1),
        'w_in': nrm(ks[7], (DEPTH, D_MODEL, N_IN), D_MODEL ** -0.5),
        'b_gate': nrm(ks[8], (DEPTH, N_BRANCH * D_MODEL), 0.1),
        'conv_w': nrm(ks[9], (DEPTH, CONV_W, LRU_WIDTH), CONV_W ** -0.5),
        'conv_b': nrm(ks[10], (DEPTH, LRU_WIDTH), 0.02),
        'w_rg': nrm(ks[11], (DEPTH, 2, LRU_BLOCKS, LRU_BLOCK, LRU_BLOCK), LRU_BLOCK ** -0.5),
        'b_rg': nrm(ks[12], (DEPTH, 2, LRU_WIDTH), 0.1),
        'w_ig': nrm(ks[13], (DEPTH, 2, LRU_BLOCKS, LRU_BLOCK, LRU_BLOCK), LRU_BLOCK ** -0.5),
        'b_ig': nrm(ks[14], (DEPTH, 2, LRU_WIDTH), 0.1),
        'lru_lambda': lru_lambda,
        'q_norm_g': 1.0 + nrm(ks[16], (DEPTH, HEAD_DIM), 0.1),
        'k_norm_g': 1.0 + nrm(ks[17], (DEPTH, HEAD_DIM), 0.1),
        'lambda_q1': nrm(ks[18], (DEPTH, HEAD_DIM), 0.1),
        'lambda_k1': nrm(ks[19], (DEPTH, HEAD_DIM), 0.1),
        'lambda_q2': nrm(ks[20], (DEPTH, HEAD_DIM), 0.1),
        'lambda_k2': nrm(ks[21], (DEPTH, HEAD_DIM), 0.1),
        'subln_g': 1.0 + nrm(ks[22], (DEPTH, DIFF_V_DIM), 0.1),
        'w_branch': nrm(ks[23], (DEPTH, N_BRANCH, BRANCH_W, D_MODEL), BRANCH_W ** -0.5),
        'w_out': nrm(ks[24], (DEPTH, D_MODEL, D_MODEL), D_MODEL ** -0.5),
        'norm2_g': 1.0 + nrm(ks[25], (DEPTH, D_MODEL), 0.1),
        'w_up': nrm(ks[26], (DEPTH, D_MODEL, D_FF), D_MODEL ** -0.5),
        'w_down': nrm(ks[27], (DEPTH, D_FF, D_MODEL), D_FF ** -0.5),
        'final_g': 1.0 + nrm(ks[28], (D_MODEL,), 0.1),
    }


def reference(x, c, ctx, c_ctx, w_mod, b_mod, norm1_g, w_in, b_gate, conv_w, conv_b, w_rg, b_rg, w_ig, b_ig, lru_lambda, q_norm_g, k_norm_g, lambda_q1, lambda_k1, lambda_q2, lambda_k2, subln_g, w_branch, w_out, norm2_g, w_up, w_down, final_g):
    rows = x.shape[1] // GRID_W
    cos, sin = axial_rope_tables(rows)
    sc = jax.nn.silu(c)
    scc = jax.nn.silu(c_ctx)
    xc = ctx
    for l in range(DEPTH):
        last = l == DEPTH - 1
        lam_init = 0.8 - 0.6 * math.exp(-0.3 * l)
        mod_l = [m[:, None, :] for m in jnp.split(sc @ w_mod[l] + b_mod[l], 6, axis=-1)]
        mod_c = [m[None, None, :] for m in jnp.split(scc @ w_mod[l] + b_mod[l], 6, axis=-1)]
        p = {
            'w_in': w_in[l], 'b_gate': b_gate[l], 'conv_w': conv_w[l], 'conv_b': conv_b[l],
            'w_rg': w_rg[l], 'b_rg': b_rg[l], 'w_ig': w_ig[l], 'b_ig': b_ig[l],
            'lru_lambda': lru_lambda[l], 'q_norm_g': q_norm_g[l], 'k_norm_g': k_norm_g[l],
            'lambda_q1': lambda_q1[l], 'lambda_k1': lambda_k1[l],
            'lambda_q2': lambda_q2[l], 'lambda_k2': lambda_k2[l],
            'subln_g': subln_g[l], 'w_branch': w_branch[l], 'w_out': w_out[l],
        }
        hl = rmsnorm(x, norm1_g[l]) * (1.0 + mod_l[1]) + mod_l[0]
        hc = rmsnorm(xc, norm1_g[l]) * (1.0 + mod_c[1]) + mod_c[0]
        yl, yc = token_mixer(hl, hc, p, lam_init, cos, sin, not last)
        x = x + mod_l[2] * yl
        x = x + mod_l[5] * sq_relu_mlp(rmsnorm(x, norm2_g[l]) * (1.0 + mod_l[4]) + mod_l[3], w_up[l], w_down[l])
        if not last:
            xc = xc + mod_c[2] * yc
            xc = xc + mod_c[5] * sq_relu_mlp(rmsnorm(xc, norm2_g[l]) * (1.0 + mod_c[4]) + mod_c[3], w_up[l], w_down[l])
    return rmsnorm(x, final_g)
```

```cpp
#include <hip/hip_runtime.h>
#include <hip/hip_cooperative_groups.h>
#include <cstdio>
#include <cstdint>
namespace cg = cooperative_groups;

#ifndef N_LAUNCH_MODE
#define N_LAUNCH_MODE 1
#endif

#define LAS __attribute__((address_space(3)))
typedef LAS unsigned char* ldsp;
typedef unsigned short bf16_t;
typedef short bf16x8 __attribute__((ext_vector_type(8)));
typedef float f32x2 __attribute__((ext_vector_type(2)));
typedef float f32x4 __attribute__((ext_vector_type(4)));
typedef float f32x16 __attribute__((ext_vector_type(16)));
typedef unsigned u32x2 __attribute__((ext_vector_type(2)));
typedef unsigned u32x4 __attribute__((ext_vector_type(4)));
typedef __bf16 bf16x2_t __attribute__((ext_vector_type(2)));

constexpr int DM = 1024, NBATCH = 4, SEQ = 8192, CTX = 256, NIN = 6400, ZW = 3328, GW = 3072, FF = 4096;
constexpr int HROWS = 16896, LROWS = 16384, MROWS = 33792;
constexpr int NKT = 132;
constexpr int NCH = 132;
constexpr float EPS = 1e-6f;
constexpr float QSCALE = 0.125f * 1.4426950408889634f;
constexpr int LDS_BYTES = 139264;

constexpr size_t al256(size_t x) { return (x + 255) & ~(size_t)255; }
constexpr size_t WS_BAR = 0, WS_BAR_BYTES = 16384;
constexpr size_t WS_MOD = 16384;
constexpr size_t WS_LAM = al256(WS_MOD + 2 * 5 * 6144 * 4);
constexpr size_t WS_ROPE = al256(WS_LAM + 256);
constexpr size_t WS_WIN = al256(WS_ROPE + (size_t)8192 * 32 * 8);
constexpr size_t WS_WBR = al256(WS_WIN + (size_t)2 * NIN * DM * 2);
constexpr size_t WS_WOUT = al256(WS_WBR + (size_t)6 * DM * 512 * 2);
constexpr size_t WS_WUP = al256(WS_WOUT + (size_t)2 * DM * DM * 2);
constexpr size_t WS_WDN = al256(WS_WUP + (size_t)2 * FF * DM * 2);
constexpr size_t WS_XS = al256(WS_WDN + (size_t)2 * FF * DM * 2);
constexpr size_t WS_H = al256(WS_XS + (size_t)MROWS * DM * 2);
constexpr size_t WS_Z = al256(WS_H + (size_t)MROWS * DM * 2);
constexpr size_t WS_G = al256(WS_Z + (size_t)HROWS * ZW * 2);
constexpr size_t WS_KG = al256(WS_Z + (size_t)MROWS * FF * 2);
constexpr size_t WS_VG = al256(WS_KG + (size_t)4 * NKT * 8192);
constexpr size_t WS_KD = al256(WS_VG + (size_t)4 * NKT * 8192);
constexpr size_t WS_VD = al256(WS_KD + (size_t)16 * NKT * 8192);
constexpr size_t WS_SUM = al256(WS_VD + (size_t)8 * NKT * 16384);
constexpr size_t WS_ST = al256(WS_SUM + (size_t)2 * NCH * 2 * 512 * 8);
constexpr size_t WS_END = al256(WS_ST + (size_t)2 * NCH * 2 * 512 * 4);
static_assert(WS_G + (size_t)HROWS * GW * 2 <= WS_KG, "g inside the Z region");
static_assert(WS_VD == WS_KD + (size_t)16 * NKT * 8192 && (size_t)128 * 65536 * 4 <= (size_t)16 * NKT * 8192 + (size_t)8 * NKT * 16384, "split-K slabs overlay the (dead) diff K/V images");
static_assert(WS_END <= (size_t)536870912, "workspace map fits 512 MiB");

struct Params;
typedef const __attribute__((address_space(4))) Params* KP;
struct Params {
    const float *x, *c, *ctx, *c_ctx, *w_mod, *b_mod, *norm1_g, *w_in, *b_gate, *conv_w, *conv_b, *w_rg, *b_rg, *w_ig, *b_ig, *lru_lambda,
        *q_norm_g, *k_norm_g, *lq1, *lk1, *lq2, *lk2, *subln_g, *w_branch, *w_out, *norm2_g, *w_up, *w_down, *final_g;
    float* out;
    unsigned char* ws;
};

__device__ __forceinline__ unsigned pk2(float lo, float hi) { f32x2 v = {lo, hi}; bf16x2_t b = __builtin_convertvector(v, bf16x2_t); return __builtin_bit_cast(unsigned, b); }
__device__ __forceinline__ float bflo(unsigned w) { return __uint_as_float(w << 16); }
__device__ __forceinline__ float bfhi(unsigned w) { return __uint_as_float(w & 0xffff0000u); }
__device__ __forceinline__ float bf2f(bf16_t h) { return __uint_as_float(((unsigned)h) << 16); }
__device__ __forceinline__ float sigmoidf_(float v) { return __builtin_amdgcn_rcpf(1.0f + __builtin_amdgcn_exp2f(-1.4426950408889634f * v)); }
__device__ __forceinline__ float wave_sum(float v) {
#pragma unroll
    for (int o = 1; o < 64; o <<= 1) v += __shfl_xor(v, o);
    return v;
}
__device__ __forceinline__ int tid_() { int t = threadIdx.x; asm volatile("" : "+v"(t)); return t; }
__device__ __forceinline__ float lam_init_of(int l) { return l == 0 ? 0.2f : (0.8f - 0.6f * 0.74081822068171786607f); }

struct RowMap { const float* src; int modrow; };
__device__ __forceinline__ RowMap rowmap(KP p, int R) {
    const int hb = R / HROWS, lr = R - hb * HROWS;
    RowMap m;
    if (lr < LROWS) { const size_t li = (size_t)hb * LROWS + lr; m.src = p->x + li * DM; m.modrow = 2 * hb + (lr >> 13); }
    else { const size_t ci = (size_t)hb * 512 + (lr - LROWS); m.src = p->ctx + ci * DM; m.modrow = 4; }
    return m;
}

namespace g8 {
constexpr int BM = 256, BK = 64, HALF = 128, HTB = HALF * BK * 2;
__device__ __forceinline__ int lds_byte(int r, int c) { const int st = (r >> 4) * 2 + (c >> 5), rr = r & 15, cc = c & 31, ob = rr * 64 + cc * 2; return st * 1024 + (ob ^ (((ob >> 9) & 1) << 5)); }
__device__ __forceinline__ void stage_rc(int b, int& R, int& C) { const int st = b / 1024, sb = b % 1024, swz = sb ^ (((sb >> 9) & 1) << 5); R = (st >> 1) * 16 + swz / 64; C = (st & 1) * 32 + (swz % 64) / 2; }
__device__ __forceinline__ int perm32(int rho) { const int n = rho >> 4, i = rho & 15; return 8 * (i >> 2) + 4 * n + (i & 3); }

struct Desc { const unsigned char *A0, *B0; int lda, ldb, nt, nseg, nM, nN, skipctx, dA, dA2, dB, xsplit; };
struct Leg { const unsigned char* A; const unsigned char* B; int R0, c0, seg, nt, slab; };

__device__ __forceinline__ bool get_leg(const Desc& g, int i, Leg& l) {
    const int ui = i / g.nseg, seg = i - ui * g.nseg;
    const int nwg = g.nM * g.nN; const long L = (long)ui * gridDim.x + blockIdx.x;
    if (L >= nwg) {
        const int x = (int)(L - nwg); if (x >= 4 * g.nN * g.xsplit) return false;
        const int ks = x % g.xsplit, t_ = x / g.xsplit, pn = t_ % g.nN, j = t_ / g.nN; const int pm = (j >> 1) * 66 + 64 + (j & 1);
        const int ntk = g.nt / g.xsplit;
        l.A = g.A0 + (size_t)pm * 256 * g.lda * 2 + (size_t)ks * ntk * 128; l.B = g.B0 + (size_t)pn * 256 * g.ldb * 2 + (size_t)ks * ntk * 128;
        l.R0 = pm * 256; l.c0 = pn * 256; l.seg = 0; l.nt = ntk; l.slab = (j * g.nN + pn) * g.xsplit + ks; return true;
    }
    int wgid = (int)L; { const int q = nwg / 8, r = nwg % 8, xcd = wgid % 8, off = wgid / 8; wgid = (xcd < r ? xcd * (q + 1) : r * (q + 1) + (xcd - r) * q) + off; }
    const int nig = 8 * g.nN, gid = wgid / nig, fm = gid * 8, gsz = (g.nM - fm) < 8 ? (g.nM - fm) : 8;
    int pm = fm + ((wgid % nig) % gsz); const int pn = (wgid % nig) / gsz;
    if (g.skipctx) pm += 2 * (pm >> 6);
    l.A = g.A0 + (size_t)pm * 256 * g.lda * 2 + seg * g.dA + (seg >> 1) * g.dA2; l.B = g.B0 + (size_t)pn * 256 * g.ldb * 2 + (size_t)seg * g.dB; l.R0 = pm * 256; l.c0 = pn * 256; l.seg = seg; l.nt = g.nt; l.slab = -1;
    return true;
}

template <class Epi>
__device__ __forceinline__ void gemm_phase(ldsp lds, const Desc& g, const Epi& E) {
    const int tid = tid_(), wid = __builtin_amdgcn_readfirstlane(tid >> 6), lane = tid & 63, wr = wid >> 2, wc = wid & 3, fr = lane & 15, fq = lane >> 4;
    unsigned voffA, voffB;
    { int R, C; stage_rc(tid * 16, R, C); const int Rb = (R & ~31) + perm32(R & 31);
        voffA = (unsigned)(R * g.lda + C) * 2u; voffB = (unsigned)(Rb * g.ldb + C) * 2u; }
    const size_t p2offA = (size_t)64 * g.lda * 2, p2offB = (size_t)64 * g.ldb * 2; const unsigned vooffA = voffA, vooffB = voffB;
    const size_t kstep = (size_t)(BK * 2);
    const size_t hstepA = (size_t)HALF * g.lda * 2, hstepB = (size_t)HALF * g.ldb * 2;
    const unsigned ldsw = (unsigned)wid * 1024u;
    const int aoff = lds_byte(wr * 64 + fr, fq * 8), boff = lds_byte(wc * 32 + fr, fq * 8);
#define G8_SA(b, h) (((b) * 2 + (h)) * HTB)
#define G8_SB(b, h) ((4 + (b) * 2 + (h)) * HTB)
#define G8_STAGE(bufoff, gbase, voff) do { _Pragma("unroll") for (int _i = 0; _i < 2; ++_i) \
        __builtin_amdgcn_global_load_lds((const unsigned*)((const unsigned char*)(gbase) + (size_t)_i * p2##voff + vo##voff), (LAS unsigned*)(lds + (bufoff) + ldsw + _i * 8192), 16, 0, 0); } while (0)
#define G8_LDA(dst, b, h) do { _Pragma("unroll") for (int m = 0; m < 4; ++m) _Pragma("unroll") for (int k = 0; k < 2; ++k) dst[m][k] = *(const LAS bf16x8*)(lds + G8_SA(b, h) + aoff + m * 2048 + k * 1024); } while (0)
#define G8_LDB(dst, b, h) do { _Pragma("unroll") for (int n = 0; n < 2; ++n) _Pragma("unroll") for (int k = 0; k < 2; ++k) dst[n][k] = *(const LAS bf16x8*)(lds + G8_SB(b, h) + boff + n * 2048 + k * 1024); } while (0)
#define G8_MMA(ai, bj, At, Bt) do { __builtin_amdgcn_s_setprio(1); _Pragma("unroll") for (int m = 0; m < 4; ++m) _Pragma("unroll") for (int n = 0; n < 2; ++n) _Pragma("unroll") for (int k = 0; k < 2; ++k) \
        acc[ai][bj][m][n] = __builtin_amdgcn_mfma_f32_16x16x32_bf16(Bt[n][k], At[m][k], acc[ai][bj][m][n], 0, 0, 0); __builtin_amdgcn_s_setprio(0); } while (0)
#define G8_WAIT_V(n) asm volatile("s_waitcnt vmcnt(" #n ")" ::: "memory")
#define G8_WAIT_L(n) asm volatile("s_waitcnt lgkmcnt(" #n ")" ::: "memory")
#define G8_BAR __builtin_amdgcn_s_barrier()
#define G8_SCHED __builtin_amdgcn_sched_barrier(0)
#define G8_ZERO() do { _Pragma("unroll") for (int a = 0; a < 2; ++a) _Pragma("unroll") for (int b = 0; b < 2; ++b) _Pragma("unroll") for (int m = 0; m < 4; ++m) _Pragma("unroll") for (int n = 0; n < 2; ++n) acc[a][b][m][n] = (f32x4){0.f, 0.f, 0.f, 0.f}; } while (0)
    Leg cur, nxt; int ui = 0;
    if (!get_leg(g, 0, cur)) return;
    f32x4 acc[2][2][4][2];
    G8_ZERO();
    bf16x8 At[4][2], B0[2][2], B1[2][2];
    const unsigned char* cA = cur.A; const unsigned char* cB = cur.B;
    G8_STAGE(G8_SB(0, 0), cB, offB); G8_STAGE(G8_SB(0, 1), cB + hstepB, offB); G8_STAGE(G8_SA(0, 0), cA, offA); G8_STAGE(G8_SA(0, 1), cA + hstepA, offA);
    if (wr == 1) G8_BAR;
    G8_WAIT_V(2); G8_BAR;
    G8_STAGE(G8_SB(1, 0), cB + kstep, offB); G8_STAGE(G8_SA(1, 0), cA + kstep, offA); G8_STAGE(G8_SB(1, 1), cB + hstepB + kstep, offB);
    G8_WAIT_V(6); G8_BAR;
    for (;;) {
        const bool has_next = get_leg(g, ui + 1, nxt);
        const unsigned char* nA = has_next ? nxt.A : cA; const unsigned char* nB = has_next ? nxt.B : cB;
        const int nt = cur.nt;
        for (int t = 0; t < nt; t += 2) {
            const bool last = (t == nt - 2);
            const unsigned char* a1 = cA + (size_t)(t + 1) * kstep;
            const unsigned char* a2 = last ? nA : cA + (size_t)(t + 2) * kstep; const unsigned char* b2 = last ? nB : cB + (size_t)(t + 2) * kstep;
            const unsigned char* a3 = a2 + kstep; const unsigned char* b3 = b2 + kstep;
            G8_LDB(B0, 0, 0); G8_LDB(B1, 0, 1); G8_SCHED; G8_LDA(At, 0, 0); G8_STAGE(G8_SA(1, 1), a1 + hstepA, offA);
            G8_WAIT_V(8); G8_WAIT_L(0); G8_BAR; G8_MMA(0, 0, At, B0); G8_MMA(0, 1, At, B1); G8_BAR; G8_SCHED;
            G8_LDA(At, 0, 1); G8_STAGE(G8_SB(0, 0), b2, offB); G8_STAGE(G8_SB(0, 1), b2 + hstepB, offB); G8_STAGE(G8_SA(0, 0), a2, offA);
            G8_WAIT_V(8); G8_WAIT_L(0); G8_BAR; G8_MMA(1, 0, At, B0); G8_MMA(1, 1, At, B1); G8_BAR; G8_SCHED;
            G8_LDB(B0, 1, 0); G8_LDB(B1, 1, 1); G8_SCHED; G8_LDA(At, 1, 0); G8_STAGE(G8_SA(0, 1), a2 + hstepA, offA);
            G8_WAIT_V(8); G8_WAIT_L(0); G8_BAR; G8_MMA(0, 0, At, B0); G8_MMA(0, 1, At, B1); G8_BAR; G8_SCHED;
            G8_LDA(At, 1, 1); G8_STAGE(G8_SB(1, 0), b3, offB); G8_STAGE(G8_SB(1, 1), b3 + hstepB, offB); G8_STAGE(G8_SA(1, 0), a3, offA);
            G8_WAIT_V(8); G8_WAIT_L(0); G8_BAR; G8_MMA(1, 0, At, B0); G8_MMA(1, 1, At, B1); G8_BAR; G8_SCHED;
        }
        if (wr == 0) G8_BAR;
        E(acc, cur, wr, wc, fr, fq);
        if (!has_next) break;
        if (cur.seg == g.nseg - 1) G8_ZERO();
        cur = nxt; cA = nA; cB = nB; ++ui;
        if (wr == 1) G8_BAR;
    }
    G8_WAIT_V(0);
    G8_BAR;
#undef G8_SA
#undef G8_SB
#undef G8_STAGE
#undef G8_LDA
#undef G8_LDB
#undef G8_MMA
#undef G8_WAIT_V
#undef G8_WAIT_L
#undef G8_BAR
#undef G8_SCHED
#undef G8_ZERO
}

#define EPI_LOOP_BEGIN \
    _Pragma("unroll") for (int ai = 0; ai < 2; ++ai) _Pragma("unroll") for (int m = 0; m < 4; ++m) { const int row = l.R0 + ai * 128 + wr * 64 + m * 16 + fr; \
    _Pragma("unroll") for (int bj = 0; bj < 2; ++bj) { const int col = l.c0 + bj * 128 + wc * 32 + 8 * fq; f32x4 v0 = acc[ai][bj][m][0], v1 = acc[ai][bj][m][1];
#define EPI_LOOP_END __builtin_amdgcn_sched_barrier(0); } }

struct EpiIn {
    bf16_t* z; bf16_t* g; const float* bgate;
    __device__ __forceinline__ void operator()(f32x4 (&acc)[2][2][4][2], const Leg& l, int wr, int wc, int fr, int fq) const {
        EPI_LOOP_BEGIN
            if (l.c0 + bj * 128 < ZW) {
                u32x4 w; w.x = pk2(v0[0], v0[1]); w.y = pk2(v0[2], v0[3]); w.z = pk2(v1[0], v1[1]); w.w = pk2(v1[2], v1[3]);
                *(u32x4*)(z + (size_t)row * ZW + col) = w;
            } else {
                const int cg_ = col - ZW; const f32x4 b0 = *(const f32x4*)(bgate + cg_), b1 = *(const f32x4*)(bgate + cg_ + 4);
                u32x4 w; w.x = pk2(sigmoidf_(v0[0] + b0[0]), sigmoidf_(v0[1] + b0[1])); w.y = pk2(sigmoidf_(v0[2] + b0[2]), sigmoidf_(v0[3] + b0[3]));
                w.z = pk2(sigmoidf_(v1[0] + b1[0]), sigmoidf_(v1[1] + b1[1])); w.w = pk2(sigmoidf_(v1[2] + b1[2]), sigmoidf_(v1[3] + b1[3]));
                *(u32x4*)(g + (size_t)row * GW + cg_) = w;
            }
        EPI_LOOP_END
    }
};
struct EpiMerge {
    const bf16_t* g; bf16_t* H; int hrow0;
    __device__ __forceinline__ void operator()(f32x4 (&acc)[2][2][4][2], const Leg& l, int wr, int wc, int fr, int fq) const {
        EPI_LOOP_BEGIN
            const bf16_t* gp = g + (size_t)row * GW + col;
            const u32x4 ga = *(const u32x4*)(gp + l.seg * 1024);
            float f[8] = {bflo(ga.x), bfhi(ga.x), bflo(ga.y), bfhi(ga.y), bflo(ga.z), bfhi(ga.z), bflo(ga.w), bfhi(ga.w)};
            if (l.seg < 2) {
                const u32x4 gb = *(const u32x4*)(gp + (l.seg + 1) * 1024);
                const float d[8] = {bflo(gb.x), bfhi(gb.x), bflo(gb.y), bfhi(gb.y), bflo(gb.z), bfhi(gb.z), bflo(gb.w), bfhi(gb.w)};
#pragma unroll
                for (int e = 0; e < 8; ++e) f[e] = f[e] * __builtin_amdgcn_rcpf(d[e]);
                acc[ai][bj][m][0] = (f32x4){v0[0] * f[0], v0[1] * f[1], v0[2] * f[2], v0[3] * f[3]};
                acc[ai][bj][m][1] = (f32x4){v1[0] * f[4], v1[1] * f[5], v1[2] * f[6], v1[3] * f[7]};
            } else {
                u32x4 w; w.x = pk2(v0[0] * f[0], v0[1] * f[1]); w.y = pk2(v0[2] * f[2], v0[3] * f[3]); w.z = pk2(v1[0] * f[4], v1[1] * f[5]); w.w = pk2(v1[2] * f[6], v1[3] * f[7]);
                *(u32x4*)(H + (size_t)(hrow0 + row) * DM + col) = w;
            }
        EPI_LOOP_END
    }
};
template <bool F32SRC> struct EpiRes {
    const float* xin; const float* cin; bf16_t* S; const float* mod; int goff; float* slabs;
    __device__ __forceinline__ void operator()(f32x4 (&acc)[2][2][4][2], const Leg& l, int wr, int wc, int fr, int fq) const {
        const int hb = l.R0 / HROWS, lr = l.R0 - hb * HROWS;
        const float* src = nullptr; int modrow;
        if (lr < LROWS) { const size_t li = (size_t)hb * LROWS + lr; if (F32SRC) src = xin + li * DM; modrow = 2 * hb + (lr >> 13); }
        else { const size_t ci = (size_t)hb * 512 + (lr - LROWS); if (F32SRC) src = cin + ci * DM; modrow = 4; }
        const float* gate = mod + (size_t)modrow * 6144 + goff;
        if (l.slab >= 0) {
            float* sb = slabs + (size_t)l.slab * 65536;
            EPI_LOOP_BEGIN
                float* q = sb + (size_t)(row - l.R0) * 256 + (col - l.c0);
                *(f32x4*)q = v0; *(f32x4*)(q + 4) = v1;
            EPI_LOOP_END
            return;
        }
        EPI_LOOP_BEGIN
            bf16_t* dp = S + (size_t)row * DM + col;
            const f32x4 gv0 = *(const f32x4*)(gate + col), gv1 = *(const f32x4*)(gate + col + 4);
            f32x4 s0, s1;
            if (F32SRC) { const size_t o = (size_t)(row - l.R0) * DM + col; s0 = *(const f32x4*)(src + o); s1 = *(const f32x4*)(src + o + 4); }
            else { const u32x4 r_ = *(const u32x4*)dp; s0 = (f32x4){bflo(r_.x), bfhi(r_.x), bflo(r_.y), bfhi(r_.y)}; s1 = (f32x4){bflo(r_.z), bfhi(r_.z), bflo(r_.w), bfhi(r_.w)}; }
            const f32x4 y0 = s0 + gv0 * v0, y1 = s1 + gv1 * v1;
            u32x4 w; w.x = pk2(y0[0], y0[1]); w.y = pk2(y0[2], y0[3]); w.z = pk2(y1[0], y1[1]); w.w = pk2(y1[2], y1[3]);
            *(u32x4*)dp = w;
        EPI_LOOP_END
    }
};
struct EpiUp {
    bf16_t* a;
    __device__ __forceinline__ void operator()(f32x4 (&acc)[2][2][4][2], const Leg& l, int wr, int wc, int fr, int fq) const {
        EPI_LOOP_BEGIN
#pragma unroll
            for (int e = 0; e < 4; ++e) { const float a0 = fmaxf(v0[e], 0.f), a1 = fmaxf(v1[e], 0.f); v0[e] = a0 * a0; v1[e] = a1 * a1; }
            u32x4 w; w.x = pk2(v0[0], v0[1]); w.y = pk2(v0[2], v0[3]); w.z = pk2(v1[0], v1[1]); w.w = pk2(v1[2], v1[3]);
            *(u32x4*)(a + (size_t)row * FF + col) = w;
        EPI_LOOP_END
    }
};
}

__device__ __forceinline__ void transpose_tile(ldsp lds, const float* src, bf16_t* dst, int K, int N, int tk, int tn) {
    const int tid = tid_();
    LAS float* T = (LAS float*)lds;
#pragma unroll
    for (int i = 0; i < 2; ++i) {
        const int k = (tid >> 4) + i * 32, n4 = (tid & 15) * 4;
        const f32x4 v = *(const f32x4*)(src + (size_t)(tk * 64 + k) * N + tn * 64 + n4);
        T[k * 65 + n4] = v[0]; T[k * 65 + n4 + 1] = v[1]; T[k * 65 + n4 + 2] = v[2]; T[k * 65 + n4 + 3] = v[3];
    }
    __syncthreads();
    const int n = tid >> 3, k8 = (tid & 7) * 8;
    u32x4 w;
    w.x = pk2(T[(k8 + 0) * 65 + n], T[(k8 + 1) * 65 + n]); w.y = pk2(T[(k8 + 2) * 65 + n], T[(k8 + 3) * 65 + n]);
    w.z = pk2(T[(k8 + 4) * 65 + n], T[(k8 + 5) * 65 + n]); w.w = pk2(T[(k8 + 6) * 65 + n], T[(k8 + 7) * 65 + n]);
    *(u32x4*)(dst + (size_t)(tn * 64 + n) * K + tk * 64 + k8) = w;
    __syncthreads();
}

__device__ __forceinline__ void phase_prologue(KP p, ldsp lds) {
    const int tid = tid_(), G = gridDim.x;
    for (int it = blockIdx.x; it < 2 * 4288; it += G) {
        const int l = it / 4288; int r = it - l * 4288;
        const float* src; bf16_t* dst; int K, N;
        if (r < 1600) { src = p->w_in + (size_t)l * DM * NIN; dst = (bf16_t*)(p->ws + WS_WIN) + (size_t)l * NIN * DM; K = DM; N = NIN; }
        else if (r < 1984) { r -= 1600; const int n = r / 128; r -= n * 128; src = p->w_branch + (size_t)(l * 3 + n) * 512 * DM; dst = (bf16_t*)(p->ws + WS_WBR) + (size_t)(l * 3 + n) * DM * 512; K = 512; N = DM; }
        else if (r < 2240) { r -= 1984; src = p->w_out + (size_t)l * DM * DM; dst = (bf16_t*)(p->ws + WS_WOUT) + (size_t)l * DM * DM; K = DM; N = DM; }
        else if (r < 3264) { r -= 2240; src = p->w_up + (size_t)l * DM * FF; dst = (bf16_t*)(p->ws + WS_WUP) + (size_t)l * FF * DM; K = DM; N = FF; }
        else { r -= 3264; src = p->w_down + (size_t)l * FF * DM; dst = (bf16_t*)(p->ws + WS_WDN) + (size_t)l * DM * FF; K = FF; N = DM; }
        const int ntn = N / 64; const int tk = r / ntn, tn = r - tk * ntn;
        transpose_tile(lds, src, dst, K, N, tk, tn);
    }
    {
        LAS float* red = (LAS float*)lds;
        float* mod = (float*)(p->ws + WS_MOD);
        for (int it = blockIdx.x; it < 768; it += G) {
            const int j0 = it * 16, l = j0 / 6144, jj0 = j0 - l * 6144, jc = tid & 15, ks = tid >> 4;
            float a0 = 0.f, a1 = 0.f, a2 = 0.f, a3 = 0.f, a4 = 0.f;
            const float* wp = p->w_mod + ((size_t)l * DM + ks * 32) * 6144 + jj0 + jc;
#pragma unroll 8
            for (int i = 0; i < 32; ++i) {
                const int k = ks * 32 + i; const float w = wp[(size_t)i * 6144];
                const float c0 = p->c[k], c1 = p->c[DM + k], c2 = p->c[2 * DM + k], c3 = p->c[3 * DM + k], c4 = p->c_ctx[k];
                a0 += c0 * sigmoidf_(c0) * w; a1 += c1 * sigmoidf_(c1) * w; a2 += c2 * sigmoidf_(c2) * w; a3 += c3 * sigmoidf_(c3) * w; a4 += c4 * sigmoidf_(c4) * w;
            }
            red[(0 * 32 + ks) * 16 + jc] = a0; red[(1 * 32 + ks) * 16 + jc] = a1; red[(2 * 32 + ks) * 16 + jc] = a2; red[(3 * 32 + ks) * 16 + jc] = a3; red[(4 * 32 + ks) * 16 + jc] = a4;
            __syncthreads();
            if (tid < 80) { const int r = tid >> 4, c = tid & 15; float s = 0.f;
                for (int q = 0; q < 32; ++q) s += red[(r * 32 + q) * 16 + c];
                mod[((size_t)l * 5 + r) * 6144 + jj0 + c] = s + p->b_mod[(size_t)l * 6144 + jj0 + c]; }
            __syncthreads();
        }
    }
    {
        f32x2* cs = (f32x2*)(p->ws + WS_ROPE);
        for (int idx = blockIdx.x * 512 + tid; idx < 8192 * 32; idx += G * 512) {
            const int t = idx >> 5, e = idx & 31, axis = e >> 4, f = e & 15;
            const float pos = (float)(axis == 0 ? (t >> 6) : (t & 63));
            const float inv = powf(10000.0f, -(float)f * (1.0f / 16.0f));
            const float ang = pos * inv;
            cs[idx] = (f32x2){cosf(ang), sinf(ang)};
        }
    }
    if (blockIdx.x == 0 && tid < 128) {
        const int l = tid >> 6, e = tid & 63;
        const float s1 = wave_sum(p->lq1[l * 64 + e] * p->lk1[l * 64 + e]), s2 = wave_sum(p->lq2[l * 64 + e] * p->lk2[l * 64 + e]);
        if (e == 0) ((float*)(p->ws + WS_LAM))[l] = expf(s1) - expf(s2) + lam_init_of(l);
    }
}

__device__ __forceinline__ void phase_norm(KP p, int layer, int which) {
    const int tid = tid_(), lane = tid & 63, wv = tid >> 6;
    const float* ng = (which == 0 ? p->norm1_g : p->norm2_g) + (size_t)layer * DM;
    bf16_t* H = (bf16_t*)(p->ws + WS_H);
    const int stride = gridDim.x * 8;
    for (int R0 = blockIdx.x * 8 + wv; R0 < MROWS; R0 += 2 * stride) {
        f32x4 v[2][4]; const float* mod[2]; bool ok[2];
#pragma unroll
        for (int u = 0; u < 2; ++u) {
            const int R = R0 + u * stride; ok[u] = R < MROWS; mod[u] = nullptr;
            if (ok[u]) {
                const RowMap rm = rowmap(p, R);
                if (layer == 1 && which == 1 && rm.modrow == 4) { ok[u] = false; continue; }
                mod[u] = (const float*)(p->ws + WS_MOD) + ((size_t)layer * 5 + rm.modrow) * 6144 + (which == 0 ? 0 : 3 * DM);
                if (layer == 0 && which == 0) {
#pragma unroll
                    for (int k = 0; k < 4; ++k) v[u][k] = *(const f32x4*)(rm.src + k * 256 + lane * 4);
                } else {
                    const bf16_t* sp_ = (const bf16_t*)(p->ws + WS_XS) + (size_t)R * DM;
#pragma unroll
                    for (int k = 0; k < 4; ++k) { const u32x2 r_ = *(const u32x2*)(sp_ + k * 256 + lane * 4); v[u][k] = (f32x4){bflo(r_.x), bfhi(r_.x), bflo(r_.y), bfhi(r_.y)}; }
                }
                if (layer == 1 && which == 0 && rm.modrow == 4) {
                    const int hb_ = R / HROWS, c_ = R - hb_ * HROWS - LROWS, j_ = hb_ * 2 + (c_ >> 8), r_ = c_ & 255;
                    const float* g2 = (const float*)(p->ws + WS_MOD) + (size_t)4 * 6144 + 5 * DM;
                    const float* sb = (const float*)(p->ws + WS_KD) + (size_t)r_ * 256 + lane * 4;
#pragma unroll
                    for (int k = 0; k < 4; ++k) { f32x4 a = (f32x4){0.f, 0.f, 0.f, 0.f};
#pragma unroll
                        for (int ks = 0; ks < 8; ++ks) a += *(const f32x4*)(sb + (size_t)((j_ * 4 + k) * 8 + ks) * 65536);
                        v[u][k] += *(const f32x4*)(g2 + k * 256 + lane * 4) * a; }
                }
            }
        }
#pragma unroll
        for (int u = 0; u < 2; ++u) {
            if (!ok[u]) continue;
            const int R = R0 + u * stride;
            float ss = 0.f;
#pragma unroll
            for (int k = 0; k < 4; ++k) ss += v[u][k][0] * v[u][k][0] + v[u][k][1] * v[u][k][1] + v[u][k][2] * v[u][k][2] + v[u][k][3] * v[u][k][3];
            ss = wave_sum(ss);
            const float rstd = rsqrtf(ss * (1.0f / DM) + EPS);
#pragma unroll
            for (int k = 0; k < 4; ++k) {
                const int c = k * 256 + lane * 4;
                const f32x4 gg = *(const f32x4*)(ng + c), sh = *(const f32x4*)(mod[u] + c), sc = *(const f32x4*)(mod[u] + DM + c);
                float y[4];
#pragma unroll
                for (int e = 0; e < 4; ++e) y[e] = v[u][k][e] * rstd * gg[e] * (1.0f + sc[e]) + sh[e];
                u32x2 w; w.x = pk2(y[0], y[1]); w.y = pk2(y[2], y[3]);
                *(u32x2*)(H + (size_t)R * DM + c) = w;
            }
        }
    }
}

__device__ __forceinline__ void phase_final(KP p) {
    const int tid = tid_(), lane = tid & 63, wv = tid >> 6;
    const int stride = gridDim.x * 8;
    const bf16_t* S = (const bf16_t*)(p->ws + WS_XS);
    for (int r0 = blockIdx.x * 8 + wv; r0 < NBATCH * SEQ; r0 += 2 * stride) {
        f32x4 v[2][4];
#pragma unroll
        for (int u = 0; u < 2; ++u) { const int r = r0 + u * stride;
            if (r < NBATCH * SEQ) { const int hb = r >> 14; const bf16_t* sp_ = S + (size_t)(hb * HROWS + (r & (LROWS - 1))) * DM;
#pragma unroll
                for (int k = 0; k < 4; ++k) { const u32x2 r_ = *(const u32x2*)(sp_ + k * 256 + lane * 4); v[u][k] = (f32x4){bflo(r_.x), bfhi(r_.x), bflo(r_.y), bfhi(r_.y)}; } } }
#pragma unroll
        for (int u = 0; u < 2; ++u) { const int r = r0 + u * stride;
            if (r < NBATCH * SEQ) {
                float* row = p->out + (size_t)r * DM; float ss = 0.f;
#pragma unroll
                for (int k = 0; k < 4; ++k) ss += v[u][k][0] * v[u][k][0] + v[u][k][1] * v[u][k][1] + v[u][k][2] * v[u][k][2] + v[u][k][3] * v[u][k][3];
                ss = wave_sum(ss);
                const float rstd = rsqrtf(ss * (1.0f / DM) + EPS);
#pragma unroll
                for (int k = 0; k < 4; ++k) { const int c = k * 256 + lane * 4; const f32x4 gg = *(const f32x4*)(p->final_g + c); *(f32x4*)(row + c) = v[u][k] * rstd * gg; }
            } }
    }
}

__device__ __forceinline__ void post_item(KP p, int l, int item, ldsp lds) {
    const int tid = tid_();
    const int lr0 = item * 32;
    const bool isctx = lr0 >= LROWS;
    int bl, t0;
    if (!isctx) { bl = lr0 >> 13; t0 = lr0 & 8191; } else { const int c = lr0 - LROWS; bl = c >> 8; t0 = c & 255; }
    const int j0 = isctx ? t0 : 256 + t0;
    const int tile = j0 >> 6, kv0 = j0 & 63;
    bf16_t* z = (bf16_t*)(p->ws + WS_Z);
    const f32x2* cs = (const f32x2*)(p->ws + WS_ROPE);
    {
        const int row = (tid >> 3) & 31, g = tid & 7, sh = tid >> 8;
        const int axis = g >> 2, half = (g >> 1) & 1, f0 = (g & 1) * 8;
        bf16_t* rowp = z + (size_t)(lr0 + row) * ZW + g * 8;
        u32x4 raw[13];
#pragma unroll
        for (int it = 0; it < 13; ++it) {
            const int slot0 = 2 * it; const int colb = slot0 < 8 ? 1024 + slot0 * 64 : slot0 < 10 ? 1536 + (slot0 - 8) * 64 : slot0 < 18 ? 1792 + (slot0 - 10) * 64 : 2304 + (slot0 - 18) * 64;
            raw[it] = *(const u32x4*)(rowp + colb + sh * 64);
        }
        f32x2 cs8[8]; float gq[8], gk[8];
        if (!isctx) { const f32x2* cp = cs + (size_t)(t0 + row) * 32 + axis * 16 + f0;
#pragma unroll
            for (int e = 0; e < 8; ++e) cs8[e] = cp[e]; }
        else {
#pragma unroll
            for (int e = 0; e < 8; ++e) cs8[e] = (f32x2){1.f, 0.f}; }
#pragma unroll
        for (int e = 0; e < 8; ++e) { gq[e] = p->q_norm_g[l * 64 + g * 8 + e]; gk[e] = p->k_norm_g[l * 64 + g * 8 + e]; }
#pragma unroll
        for (int it = 0; it < 13; ++it) {
            const int slot0 = 2 * it; const int slot = slot0 + sh;
            const int colb = slot0 < 8 ? 1024 + slot0 * 64 : slot0 < 10 ? 1536 + (slot0 - 8) * 64 : slot0 < 18 ? 1792 + (slot0 - 10) * 64 : 2304 + (slot0 - 18) * 64;
            const u32x4 rw = raw[it];
            float x[8] = {bflo(rw.x), bfhi(rw.x), bflo(rw.y), bfhi(rw.y), bflo(rw.z), bfhi(rw.z), bflo(rw.w), bfhi(rw.w)};
            if (slot0 < 10) {
                float ss = 0.f;
#pragma unroll
                for (int e = 0; e < 8; ++e) ss += x[e] * x[e];
                ss += __shfl_xor(ss, 1); ss += __shfl_xor(ss, 2); ss += __shfl_xor(ss, 4);
                const float rstd = rsqrtf(ss * (1.0f / 64.0f) + EPS);
#pragma unroll
                for (int e = 0; e < 8; ++e) x[e] = x[e] * rstd * (slot0 < 8 ? gq[e] : gk[e]);
            }
            if (!isctx) {
#pragma unroll
                for (int e = 0; e < 8; ++e) {
                    const float o = __shfl_xor(x[e], 2); const f32x2 c = cs8[e];
                    x[e] = (half == 0) ? (x[e] * c[0] - o * c[1]) : (o * c[1] + x[e] * c[0]);
                }
            }
            const bool isq = (slot0 < 8) || (slot0 >= 10 && slot0 < 18);
            if (isq) {
#pragma unroll
                for (int e = 0; e < 8; ++e) x[e] *= QSCALE;
            }
            u32x4 w; w.x = pk2(x[0], x[1]); w.y = pk2(x[2], x[3]); w.z = pk2(x[4], x[5]); w.w = pk2(x[6], x[7]);
            if (isq) *(u32x4*)(rowp + colb + sh * 64) = w;
            else {
                const int kv = kv0 + row;
                unsigned char* dst = (slot0 < 10) ? p->ws + WS_KG + ((size_t)(bl * 2 + (slot - 8)) * NKT + tile) * 8192 : p->ws + WS_KD + ((size_t)(bl * 8 + (slot - 18)) * NKT + tile) * 8192;
                *(u32x4*)(dst + g * 1024 + kv * 16) = w;
            }
        }
    }
    {
        constexpr int PITCH = 1296;
        u32x4 vr[5];
#pragma unroll
        for (int i = 0; i < 5; ++i) {
            const int pc = i * 512 + tid; const int row = pc / 80, c8 = pc - row * 80;
            const int col = (c8 < 16) ? 1664 + c8 * 8 : 2816 + (c8 - 16) * 8;
            vr[i] = *(const u32x4*)(z + (size_t)(lr0 + row) * ZW + col);
        }
#pragma unroll
        for (int i = 0; i < 5; ++i) { const int pc = i * 512 + tid; const int row = pc / 80, c8 = pc - row * 80; *(LAS u32x4*)(lds + row * PITCH + c8 * 16) = vr[i]; }
        __syncthreads();
#pragma unroll
        for (int i = 0; i < 5; ++i) {
            const int task = i * 512 + tid; const int pp = task & 3, dcol = task >> 2;
            const int sl = pp >> 1, hi = pp & 1;
            unsigned short e[8];
#pragma unroll
            for (int q = 0; q < 8; ++q) { const int rr = 16 * sl + 8 * (q >> 2) + 4 * hi + (q & 3); e[q] = *(const LAS unsigned short*)(lds + rr * PITCH + dcol * 2); }
            u32x4 w; w.x = e[0] | ((unsigned)e[1] << 16); w.y = e[2] | ((unsigned)e[3] << 16); w.z = e[4] | ((unsigned)e[5] << 16); w.w = e[6] | ((unsigned)e[7] << 16);
            const int piece = (kv0 >> 3) + pp;
            unsigned char* dst; int d;
            if (dcol < 128) { const int kh = dcol >> 6; d = dcol & 63; dst = p->ws + WS_VG + ((size_t)(bl * 2 + kh) * NKT + tile) * 8192; }
            else { const int dc = dcol - 128, h = dc >> 7; d = dc & 127; dst = p->ws + WS_VD + ((size_t)(bl * 4 + h) * NKT + tile) * 16384; }
            *(u32x4*)(dst + d * 128 + ((piece ^ ((d >> 1) & 7)) * 16)) = w;
        }
        __syncthreads();
    }
}

constexpr int LRU_U = 0, LRU_W = 9216, LRU_AB = 46080, LRU_CP = 111616;
struct LruPre { u32x4 raw[4]; u32x4 gate; float st; };
struct LruItem { int nb, bl, ci, T, ts0, lrow0; };
__device__ __forceinline__ LruItem lru_decode(int item) {
    LruItem q; q.nb = item & 7; const int cidx = item >> 3; q.bl = cidx / NCH; q.ci = cidx - q.bl * NCH;
    const bool isctx = q.ci < 4; q.T = isctx ? CTX : SEQ; q.ts0 = isctx ? q.ci * 64 : (q.ci - 4) * 64;
    q.lrow0 = isctx ? LROWS + q.bl * 256 + q.ts0 : q.bl * 8192 + q.ts0; return q;
}
__device__ __forceinline__ void lru_prefetch(KP p, int item, int pass, int tid, LruPre& q) {
    const LruItem I = lru_decode(item);
    const bf16_t* z = (const bf16_t*)(p->ws + WS_Z);
    const int tok = tid >> 3, ch = I.nb * 64 + (tid & 7) * 8;
#pragma unroll
    for (int j = 0; j < 4; ++j) { const int ts = I.ts0 + tok + j - 2; u32x4 v = (u32x4){0u, 0u, 0u, 0u};
        if (ts >= 0 && ts < I.T) v = *(const u32x4*)(z + (size_t)(I.lrow0 + tok + j - 2) * ZW + ch);
        q.raw[j] = v; }
    if (pass == 2) {
        q.gate = *(const u32x4*)(z + (size_t)(I.lrow0 + tok) * ZW + 512 + ch);
        q.st = ((const float*)(p->ws + WS_ST))[(((size_t)I.bl * NCH + I.ci) * 2 + (tid >> 8)) * 512 + I.nb * 64 + (tid & 63)];
    }
}
__device__ __forceinline__ float fast_sigmoid(float v) { return __builtin_amdgcn_rcpf(1.0f + __builtin_amdgcn_exp2f(-1.4426950408889634f * v)); }

__device__ __forceinline__ void phase_lru(KP p, int l, int pass, ldsp lds, int qidx) {
    const int tid = tid_(), lane = tid & 63, wid = tid >> 6;
    constexpr int NPER = 2 * NCH;
    const int nbq = blockIdx.x & 7;
    unsigned* ctr = (unsigned*)p->ws + 3700 + qidx * 8 + nbq;
    volatile LAS int* tk = (volatile LAS int*)(lds + LDS_BYTES - 48);
    if (tid == 0) { tk[0] = (int)__hip_atomic_fetch_add(ctr, 1u, __ATOMIC_RELAXED, __HIP_MEMORY_SCOPE_AGENT); tk[1] = (int)__hip_atomic_fetch_add(ctr, 1u, __ATOMIC_RELAXED, __HIP_MEMORY_SCOPE_AGENT); }
    __syncthreads();
    int tcur = __builtin_amdgcn_readfirstlane(tk[0]), tnxt = __builtin_amdgcn_readfirstlane(tk[1]);
    __syncthreads();
    if (tcur >= NPER) return;
    int it = tcur * 8 + nbq;
    bf16_t* z = (bf16_t*)(p->ws + WS_Z);
    LruPre cur, nxt; lru_prefetch(p, it, pass, tid, cur);
    int cached_nb = -1;
    float cw[4][8], cb[8], brg = 0.f, big = 0.f, sp = 0.f;
    const int tok1 = tid >> 3, c8 = tid & 7;
    const int dir = wid >> 2, th = (wid >> 1) & 1, nt_ = wid & 1, r32 = lane & 31, hi = lane >> 5, chl = nt_ * 32 + r32;
    const int sdir = tid >> 8, ssub = (tid >> 6) & 3, sch = tid & 63;
    for (;;) {
        int tnn = NPER;
        if (tid == 0 && tnxt < NPER) tnn = (int)__hip_atomic_fetch_add(ctr, 1u, __ATOMIC_RELAXED, __HIP_MEMORY_SCOPE_AGENT);
        const LruItem I = lru_decode(it); const int nb = I.nb;
        if (cached_nb != nb) {
            for (int e = tid; e < 4 * 4096; e += 512) {
                const int mat = e >> 12, k = (e >> 6) & 63, n = e & 63; const int d_ = mat >> 1;
                const float* W = ((mat & 1) ? p->w_ig : p->w_rg) + ((((size_t)l * 2 + d_) * 8 + nb) * 64 + k) * 64 + n;
                *(LAS unsigned short*)(lds + LRU_W + (mat * 64 + n) * 144 + k * 2) = (unsigned short)(pk2(*W, 0.f) & 0xffffu);
            }
            const int ch = nb * 64 + c8 * 8;
#pragma unroll
            for (int j = 0; j < 4; ++j) { const f32x4 w0 = *(const f32x4*)(p->conv_w + ((size_t)l * 4 + j) * 512 + ch), w1 = *(const f32x4*)(p->conv_w + ((size_t)l * 4 + j) * 512 + ch + 4);
                cw[j][0] = w0[0]; cw[j][1] = w0[1]; cw[j][2] = w0[2]; cw[j][3] = w0[3]; cw[j][4] = w1[0]; cw[j][5] = w1[1]; cw[j][6] = w1[2]; cw[j][7] = w1[3]; }
            { const f32x4 b0 = *(const f32x4*)(p->conv_b + (size_t)l * 512 + ch), b1 = *(const f32x4*)(p->conv_b + (size_t)l * 512 + ch + 4);
              cb[0] = b0[0]; cb[1] = b0[1]; cb[2] = b0[2]; cb[3] = b0[3]; cb[4] = b1[0]; cb[5] = b1[1]; cb[6] = b1[2]; cb[7] = b1[3]; }
            const size_t pi = ((size_t)l * 2 + dir) * 512 + nb * 64 + chl;
            brg = p->b_rg[pi]; big = p->b_ig[pi];
            const float lamv = p->lru_lambda[pi];
            { const float xe = __expf(-lamv);
              const float ser = xe * (1.0f - xe * (0.5f - xe * ((1.0f / 3.0f) - xe * 0.25f)));
              sp = (lamv < -20.f) ? -lamv : ((xe < 0.03f) ? ser : __logf(1.0f + xe)); }
            cached_nb = nb;
        }
        if (tnxt < NPER) lru_prefetch(p, tnxt * 8 + nbq, pass, tid, nxt);
        {
            float a[8];
#pragma unroll
            for (int e = 0; e < 8; ++e) a[e] = cb[e];
#pragma unroll
            for (int j = 0; j < 4; ++j) { const u32x4 raw = cur.raw[j];
                a[0] += bflo(raw.x) * cw[j][0]; a[1] += bfhi(raw.x) * cw[j][1]; a[2] += bflo(raw.y) * cw[j][2]; a[3] += bfhi(raw.y) * cw[j][3];
                a[4] += bflo(raw.z) * cw[j][4]; a[5] += bfhi(raw.z) * cw[j][5]; a[6] += bflo(raw.w) * cw[j][6]; a[7] += bfhi(raw.w) * cw[j][7]; }
            u32x4 w; w.x = pk2(a[0], a[1]); w.y = pk2(a[2], a[3]); w.z = pk2(a[4], a[5]); w.w = pk2(a[6], a[7]);
            *(LAS u32x4*)(lds + LRU_U + tok1 * 144 + c8 * 16) = w;
        }
        __syncthreads();
        {
            f32x16 ar = {}, aig = {};
#pragma unroll
            for (int ks = 0; ks < 4; ++ks) {
                const bf16x8 a = *(const LAS bf16x8*)(lds + LRU_U + (th * 32 + r32) * 144 + (2 * ks + hi) * 16);
                const bf16x8 br = *(const LAS bf16x8*)(lds + LRU_W + ((dir * 2 + 0) * 64 + nt_ * 32 + r32) * 144 + (2 * ks + hi) * 16);
                const bf16x8 bi = *(const LAS bf16x8*)(lds + LRU_W + ((dir * 2 + 1) * 64 + nt_ * 32 + r32) * 144 + (2 * ks + hi) * 16);
                ar = __builtin_amdgcn_mfma_f32_32x32x16_bf16(a, br, ar, 0, 0, 0);
                aig = __builtin_amdgcn_mfma_f32_32x32x16_bf16(a, bi, aig, 0, 0, 0);
            }
#pragma unroll
            for (int r = 0; r < 16; ++r) {
                const int tok = th * 32 + (r & 3) + 8 * (r >> 2) + 4 * hi;
                const float rg = fast_sigmoid(ar[r] + brg), ig = fast_sigmoid(aig[r] + big);
                const float log_a = -8.0f * rg * sp;
                const float av = __builtin_amdgcn_exp2f(1.4426950408889634f * log_a);
                const float x = 2.0f * log_a;
                const float poly = -x * (1.0f + x * 0.5f * (1.0f + x * (1.0f / 3.0f) * (1.0f + x * 0.25f * (1.0f + x * 0.2f))));
                const float em = (x > -0.25f) ? poly : (1.0f - av * av);
                const float uu = bf2f(*(const LAS unsigned short*)(lds + LRU_U + tok * 144 + chl * 2));
                const float bv = __builtin_amdgcn_sqrtf(fmaxf(em, 0.f)) * (ig * uu);
                *(LAS f32x2*)(lds + LRU_AB + ((dir * 64 + tok) * 64 + chl) * 8) = (f32x2){av, bv};
            }
        }
        if (tid == 0) tk[0] = tnn;
        __syncthreads();
        const int tnn_all = __builtin_amdgcn_readfirstlane(tk[0]);
        {
            float A = 1.f, B = 0.f;
#pragma unroll
            for (int i = 0; i < 16; ++i) {
                const int tok = ssub * 16 + (sdir == 0 ? i : 15 - i);
                const f32x2 ab = *(const LAS f32x2*)(lds + LRU_AB + ((sdir * 64 + tok) * 64 + sch) * 8);
                B = ab[0] * B + ab[1]; A = ab[0] * A;
            }
            *(LAS f32x2*)(lds + LRU_CP + ((sdir * 4 + ssub) * 64 + sch) * 8) = (f32x2){A, B};
        }
        __syncthreads();
        if (pass == 1) {
            if (ssub == 0) {
                float A = 1.f, B = 0.f;
#pragma unroll
                for (int i = 0; i < 4; ++i) {
                    const int s_ = (sdir == 0) ? i : 3 - i;
                    const f32x2 cp = *(const LAS f32x2*)(lds + LRU_CP + ((sdir * 4 + s_) * 64 + sch) * 8);
                    B = cp[0] * B + cp[1]; A = cp[0] * A;
                }
                ((f32x2*)(p->ws + WS_SUM))[(((size_t)I.bl * NCH + I.ci) * 2 + sdir) * 512 + nb * 64 + sch] = (f32x2){A, B};
            }
        } else {
            {
                float h = cur.st;
#pragma unroll
                for (int i = 0; i < 3; ++i) {
                    const int s_ = (sdir == 0) ? i : 3 - i;
                    const bool before = (sdir == 0) ? (s_ < ssub) : (s_ > ssub);
                    const f32x2 cp = *(const LAS f32x2*)(lds + LRU_CP + ((sdir * 4 + s_) * 64 + sch) * 8);
                    if (before) h = cp[0] * h + cp[1];
                }
#pragma unroll
                for (int i = 0; i < 16; ++i) {
                    const int tok = ssub * 16 + (sdir == 0 ? i : 15 - i);
                    LAS f32x2* q = (LAS f32x2*)(lds + LRU_AB + ((sdir * 64 + tok) * 64 + sch) * 8);
                    const f32x2 ab = *q;
                    h = ab[0] * h + ab[1];
                    (*q)[0] = h;
                }
            }
            __syncthreads();
            {
                bf16_t* gp = z + (size_t)(I.lrow0 + tok1) * ZW + 512 + nb * 64 + c8 * 8;
                const u32x4 raw = cur.gate;
                const float gt[8] = {bflo(raw.x), bfhi(raw.x), bflo(raw.y), bfhi(raw.y), bflo(raw.z), bfhi(raw.z), bflo(raw.w), bfhi(raw.w)};
                float y[8];
#pragma unroll
                for (int e = 0; e < 8; ++e) {
                    const float hf = (*(const LAS f32x2*)(lds + LRU_AB + ((0 * 64 + tok1) * 64 + c8 * 8 + e) * 8))[0];
                    const float hb_ = (*(const LAS f32x2*)(lds + LRU_AB + ((1 * 64 + tok1) * 64 + c8 * 8 + e) * 8))[0];
                    const float v = gt[e];
                    const float inner = 0.7978845608028654f * (v + 0.044715f * v * v * v);
                    const float th_ = 1.0f - 2.0f * __builtin_amdgcn_rcpf(1.0f + __builtin_amdgcn_exp2f(2.885390081777927f * inner));
                    y[e] = (hf + hb_) * (0.5f * v * (1.0f + th_));
                }
                u32x4 w; w.x = pk2(y[0], y[1]); w.y = pk2(y[2], y[3]); w.z = pk2(y[4], y[5]); w.w = pk2(y[6], y[7]);
                *(u32x4*)gp = w;
            }
        }
        if (tnxt >= NPER) break;
        cur = nxt; it = tnxt * 8 + nbq; tnxt = tnn_all;
    }
    __syncthreads();
}

__device__ __forceinline__ void carry_item(KP p, int item, ldsp lds) {
    const int tid = tid_();
    const int bl = item >> 4, dir = (item >> 3) & 1, nb = item & 7;
    const f32x2* sum = (const f32x2*)(p->ws + WS_SUM);
    float* st = (float*)(p->ws + WS_ST);
    for (int e = tid; e < NCH * 64; e += 512) { const int ci = e >> 6, ch = e & 63;
        *(LAS f32x2*)(lds + e * 8) = sum[(((size_t)bl * NCH + ci) * 2 + dir) * 512 + nb * 64 + ch]; }
    __syncthreads();
    if (tid < 64) {
        float h = 0.f;
        for (int i = 0; i < NCH; ++i) {
            int ci;
            if (dir == 0) ci = i; else ci = (i < 4) ? 3 - i : (NCH - 1) - (i - 4);
            st[(((size_t)bl * NCH + ci) * 2 + dir) * 512 + nb * 64 + tid] = h;
            const f32x2 ab = *(const LAS f32x2*)(lds + (ci * 64 + tid) * 8);
            h = ab[0] * h + ab[1];
        }
    }
    __syncthreads();
}

template <int DV>
__device__ __forceinline__ void attn_pass(ldsp lds, const bf16x8 (&qr)[4], const unsigned char* Kt, const unsigned char* Vt, int NT, f32x16 (&o)[DV / 32], float& lsum) {
    constexpr int VB = DV * 128, NV = DV / 64, VOFF = 24576;
    const int tid = tid_(), lane = tid & 63, r32 = lane & 31, hi = lane >> 5;
    const int wid = __builtin_amdgcn_readfirstlane(tid >> 6);
    const unsigned char* ksrc = Kt + tid * 16; const unsigned char* vsrc = Vt + tid * 16;
    const ldsp kdst = lds + wid * 1024, vdst = lds + VOFF + wid * 1024;
#define ATT_LOAD(t, buf) do { __builtin_amdgcn_global_load_lds((const unsigned*)(ksrc + (size_t)(t) * 8192), (LAS unsigned*)(kdst + (buf) * 8192), 16, 0, 0); \
        _Pragma("unroll") for (int i = 0; i < NV; ++i) __builtin_amdgcn_global_load_lds((const unsigned*)(vsrc + (size_t)(t) * VB + i * 8192), (LAS unsigned*)(vdst + (buf) * VB + i * 8192), 16, 0, 0); } while (0)
    ATT_LOAD(0, 0);
    if (NT > 1) ATT_LOAD(1, 1);
    if (NT > 1) { if (DV == 64) asm volatile("s_waitcnt vmcnt(2)" ::: "memory"); else asm volatile("s_waitcnt vmcnt(3)" ::: "memory"); }
    else asm volatile("s_waitcnt vmcnt(0)" ::: "memory");
    __builtin_amdgcn_s_barrier();
    f32x16 osum = (f32x16){};
    bf16x8 ones; { const short one = (r32 == 0) ? (short)0x3F80 : (short)0; ones = (bf16x8){one, one, one, one, one, one, one, one}; }
    float mref = 0.f, lacc = 0.f;
    f32x16 negm = (f32x16){};
#pragma unroll
    for (int d = 0; d < DV / 32; ++d) o[d] = (f32x16){};
    const int kfo = hi * 1024 + r32 * 16, vfo = r32 * 128, vx = (r32 >> 1) & 7;
    constexpr float THR = 8.0f;
    const float PINF = __builtin_inff();
    int cur = 0;
    for (int t = 0; t < NT; ++t) {
        const bool more2 = (t + 2 < NT);
        { const int nb2 = (cur == 0) ? 2 : cur - 1;
          if (more2) ATT_LOAD(t + 2, nb2); }
        const ldsp kb = lds + cur * 8192 + kfo;
        bf16x8 kf[8];
#pragma unroll
        for (int d0 = 0; d0 < 4; ++d0) { kf[2 * d0] = *(const LAS bf16x8*)(kb + d0 * 2048); kf[2 * d0 + 1] = *(const LAS bf16x8*)(kb + d0 * 2048 + 512); }
        __builtin_amdgcn_sched_barrier(0);
        f32x16 p0 = __builtin_amdgcn_mfma_f32_32x32x16_bf16(kf[0], qr[0], negm, 0, 0, 0);
        f32x16 p1 = __builtin_amdgcn_mfma_f32_32x32x16_bf16(kf[1], qr[0], negm, 0, 0, 0);
#pragma unroll
        for (int d0 = 1; d0 < 4; ++d0) {
            p0 = __builtin_amdgcn_mfma_f32_32x32x16_bf16(kf[2 * d0], qr[d0], p0, 0, 0, 0);
            p1 = __builtin_amdgcn_mfma_f32_32x32x16_bf16(kf[2 * d0 + 1], qr[d0], p1, 0, 0, 0);
        }
        __builtin_amdgcn_sched_barrier(0);
        const ldsp vb = lds + VOFF + cur * VB + vfo;
        bf16x8 va[4], vc[4];
#pragma unroll
        for (int s = 0; s < 4; ++s) va[s] = *(const LAS bf16x8*)(vb + (((2 * s + hi) ^ vx) * 16));
        __builtin_amdgcn_sched_barrier(0);
        float m0 = __builtin_amdgcn_fmed3f(__builtin_amdgcn_fmed3f(p0[0], p0[1], PINF), p0[2], PINF), m1 = __builtin_amdgcn_fmed3f(__builtin_amdgcn_fmed3f(p1[0], p1[1], PINF), p1[2], PINF);
#pragma unroll
        for (int r = 3; r < 15; r += 2) {
            m0 = __builtin_amdgcn_fmed3f(__builtin_amdgcn_fmed3f(m0, p0[r], PINF), p0[r + 1], PINF);
            m1 = __builtin_amdgcn_fmed3f(__builtin_amdgcn_fmed3f(m1, p1[r], PINF), p1[r + 1], PINF);
        }
        float mx = __builtin_amdgcn_fmed3f(__builtin_amdgcn_fmed3f(m0, p0[15], PINF), __builtin_amdgcn_fmed3f(m1, p1[15], PINF), PINF);
        { auto rr = __builtin_amdgcn_permlane32_swap(__float_as_uint(mx), __float_as_uint(mx), false, false);
          mx = __builtin_amdgcn_fmed3f(__uint_as_float(rr[0]), __uint_as_float(rr[1]), PINF); }
        if (t == 0 || __any(mx > THR)) {
            const float dl = (t == 0) ? mx : fmaxf(mx, 0.f);
            const float f = (t == 0) ? 0.f : __builtin_amdgcn_exp2f(-dl);
            mref += dl; osum[0] *= f;
#pragma unroll
            for (int r = 0; r < 16; ++r) { p0[r] -= dl; p1[r] -= dl; negm[r] = -mref; }
            asm volatile("" : "+v"(negm));
#pragma unroll
            for (int d = 0; d < DV / 32; ++d)
#pragma unroll
                for (int r = 0; r < 16; ++r) o[d][r] *= f;
        }
        bf16x8 pb[4];
#pragma unroll
        for (int r = 0; r < 16; ++r) p0[r] = __builtin_amdgcn_exp2f(p0[r]);
        { u32x4 w;
          w.x = pk2(p0[0], p0[1]); w.y = pk2(p0[2], p0[3]); w.z = pk2(p0[4], p0[5]); w.w = pk2(p0[6], p0[7]); pb[0] = __builtin_bit_cast(bf16x8, w);
          w.x = pk2(p0[8], p0[9]); w.y = pk2(p0[10], p0[11]); w.z = pk2(p0[12], p0[13]); w.w = pk2(p0[14], p0[15]); pb[1] = __builtin_bit_cast(bf16x8, w); }
#pragma unroll
        for (int s = 0; s < 4; ++s) vc[s] = *(const LAS bf16x8*)(vb + 4096 + (((2 * s + hi) ^ vx) * 16));
        __builtin_amdgcn_sched_barrier(0);
#pragma unroll
        for (int s = 0; s < 2; ++s) {
            osum = __builtin_amdgcn_mfma_f32_32x32x16_bf16(ones, pb[s], osum, 0, 0, 0);
            o[0] = __builtin_amdgcn_mfma_f32_32x32x16_bf16(va[s], pb[s], o[0], 0, 0, 0);
            if (DV == 64) o[1] = __builtin_amdgcn_mfma_f32_32x32x16_bf16(vc[s], pb[s], o[1], 0, 0, 0);
        }
#pragma unroll
        for (int r = 0; r < 16; ++r) p1[r] = __builtin_amdgcn_exp2f(p1[r]);
        { u32x4 w;
          w.x = pk2(p1[0], p1[1]); w.y = pk2(p1[2], p1[3]); w.z = pk2(p1[4], p1[5]); w.w = pk2(p1[6], p1[7]); pb[2] = __builtin_bit_cast(bf16x8, w);
          w.x = pk2(p1[8], p1[9]); w.y = pk2(p1[10], p1[11]); w.z = pk2(p1[12], p1[13]); w.w = pk2(p1[14], p1[15]); pb[3] = __builtin_bit_cast(bf16x8, w); }
        if (DV == 64) {
#pragma unroll
            for (int i = 0; i < 6; ++i) { __builtin_amdgcn_sched_group_barrier(0x008, 1, 0); __builtin_amdgcn_sched_group_barrier(0x402, 4, 0); }
        } else {
#pragma unroll
            for (int i = 0; i < 4; ++i) { __builtin_amdgcn_sched_group_barrier(0x008, 1, 0); __builtin_amdgcn_sched_group_barrier(0x402, 6, 0); }
        }
        __builtin_amdgcn_sched_barrier(0);
#pragma unroll
        for (int s = 2; s < 4; ++s) {
            osum = __builtin_amdgcn_mfma_f32_32x32x16_bf16(ones, pb[s], osum, 0, 0, 0);
            o[0] = __builtin_amdgcn_mfma_f32_32x32x16_bf16(va[s], pb[s], o[0], 0, 0, 0);
            if (DV == 64) o[1] = __builtin_amdgcn_mfma_f32_32x32x16_bf16(vc[s], pb[s], o[1], 0, 0, 0);
        }
        if (DV == 128) {
#pragma unroll
            for (int d = 1; d < DV / 32; ++d) {
                if (d + 1 < DV / 32) {
#pragma unroll
                    for (int s = 0; s < 4; ++s) { const bf16x8 x = *(const LAS bf16x8*)(vb + (d + 1) * 4096 + (((2 * s + hi) ^ vx) * 16)); if (d & 1) va[s] = x; else vc[s] = x; }
                }
                __builtin_amdgcn_sched_barrier(0);
#pragma unroll
                for (int s = 0; s < 4; ++s) o[d] = __builtin_amdgcn_mfma_f32_32x32x16_bf16((d & 1) ? vc[s] : va[s], pb[s], o[d], 0, 0, 0);
                __builtin_amdgcn_sched_barrier(0);
            }
        }
        if (more2) { if (DV == 64) asm volatile("s_waitcnt vmcnt(2) lgkmcnt(0)" ::: "memory"); else asm volatile("s_waitcnt vmcnt(3) lgkmcnt(0)" ::: "memory"); }
        else asm volatile("s_waitcnt vmcnt(0) lgkmcnt(0)" ::: "memory");
        __builtin_amdgcn_s_barrier();
        cur = (cur == 2) ? 0 : cur + 1;
    }
#undef ATT_LOAD
    { const float l0 = (hi == 0) ? osum[0] : 0.f; (void)lacc;
      auto rr = __builtin_amdgcn_permlane32_swap(__float_as_uint(l0), __float_as_uint(l0), false, false); lsum = __uint_as_float(rr[0]) + __uint_as_float(rr[1]); }
}

__device__ __forceinline__ void gqa_unit(KP p, int bl, int head, int qrow0, int NT, ldsp lds) {
    const int tid = tid_(), lane = tid & 63, wid = tid >> 6, r32 = lane & 31, hi = lane >> 5;
    bf16_t* qp = (bf16_t*)(p->ws + WS_Z) + (size_t)(qrow0 + wid * 32 + r32) * ZW + 1024 + head * 64;
    bf16x8 qr[4];
#pragma unroll
    for (int d0 = 0; d0 < 4; ++d0) qr[d0] = *(const bf16x8*)(qp + d0 * 16 + hi * 8);
    const int kh = head >> 2;
    f32x16 o[2]; float ls;
    attn_pass<64>(lds, qr, p->ws + WS_KG + (size_t)(bl * 2 + kh) * NKT * 8192, p->ws + WS_VG + (size_t)(bl * 2 + kh) * NKT * 8192, NT, o, ls);
    const float inv = 1.0f / ls;
#pragma unroll
    for (int d = 0; d < 2; ++d)
#pragma unroll
        for (int g = 0; g < 4; ++g) {
            u32x2 w; w.x = pk2(o[d][4 * g] * inv, o[d][4 * g + 1] * inv); w.y = pk2(o[d][4 * g + 2] * inv, o[d][4 * g + 3] * inv);
            *(u32x2*)(qp + d * 32 + 8 * g + 4 * hi) = w;
        }
}

__device__ __forceinline__ void diff_unit(KP p, int l, int bl, int h, int qrow0, int NT, ldsp lds) {
    const int tid = tid_(), lane = tid & 63, wid = tid >> 6, r32 = lane & 31, hi = lane >> 5;
    bf16_t* qp = (bf16_t*)(p->ws + WS_Z) + (size_t)(qrow0 + wid * 32 + r32) * ZW + 1792 + h * 128;
    f32x4* stash = (f32x4*)(p->out + ((size_t)blockIdx.x * 512 + tid) * 64);
    const float lam = ((const float*)(p->ws + WS_LAM))[l];
    f32x16 o[4]; float ls;
    for (int j = 0; j < 2; ++j) {
        bf16x8 qr[4];
#pragma unroll
        for (int d0 = 0; d0 < 4; ++d0) qr[d0] = *(const bf16x8*)(qp + j * 64 + d0 * 16 + hi * 8);
        attn_pass<128>(lds, qr, p->ws + WS_KD + (size_t)(bl * 8 + 2 * h + j) * NKT * 8192, p->ws + WS_VD + (size_t)(bl * 4 + h) * NKT * 16384, NT, o, ls);
        const float inv = 1.0f / ls;
        if (j == 0) {
#pragma unroll
            for (int d = 0; d < 4; ++d)
#pragma unroll
                for (int g = 0; g < 4; ++g) stash[d * 4 + g] = (f32x4){o[d][4 * g] * inv, o[d][4 * g + 1] * inv, o[d][4 * g + 2] * inv, o[d][4 * g + 3] * inv};
        } else {
            float ss = 0.f;
#pragma unroll
            for (int d = 0; d < 4; ++d)
#pragma unroll
                for (int g = 0; g < 4; ++g) { const f32x4 s1 = stash[d * 4 + g];
#pragma unroll
                    for (int e = 0; e < 4; ++e) { const float v = s1[e] - lam * (o[d][4 * g + e] * inv); o[d][4 * g + e] = v; ss = __builtin_fmaf(v, v, ss); }
                    __builtin_amdgcn_sched_barrier(0); }
            ss += __shfl_xor(ss, 32);
            const float rstd = rsqrtf(ss * (1.0f / 128.0f) + EPS) * (1.0f - lam_init_of(l));
            const float* sg = p->subln_g + (size_t)l * 128;
#pragma unroll
            for (int d = 0; d < 4; ++d)
#pragma unroll
                for (int g = 0; g < 4; ++g) {
                    const int dd = d * 32 + 8 * g + 4 * hi;
                    const f32x4 gg = *(const f32x4*)(sg + dd);
                    u32x2 w; w.x = pk2(o[d][4 * g] * rstd * gg[0], o[d][4 * g + 1] * rstd * gg[1]); w.y = pk2(o[d][4 * g + 2] * rstd * gg[2], o[d][4 * g + 3] * rstd * gg[3]);
                    *(u32x2*)(qp + dd) = w;
                }
        }
    }
}

__device__ __forceinline__ void phase_post(KP p, int l, int hb, ldsp lds) {
    const int G = gridDim.x;
    for (int it = blockIdx.x; it < HROWS / 32; it += G) post_item(p, l, it, lds);
    phase_lru(p, l, 1, lds, (l * 2 + hb) * 2 + 0);
}
__device__ __forceinline__ void phase_carry(KP p, ldsp lds) {
    for (int it = blockIdx.x; it < 32; it += gridDim.x) carry_item(p, it, lds);
}
__device__ __forceinline__ void phase_mix(KP p, int l, int hb, ldsp lds) {
    const int G = gridDim.x;
    const int nctx = (l == 0) ? 24 : 0;
    const int total = 256 + 512 + nctx;
    int b0_ = blockIdx.x; asm volatile("" : "+s"(b0_));
    for (int it = b0_; it < total; it += G) {
        int isdiff, bl, head, qrow0, NT = NKT;
        if (it < 256) { const int combo = it & 7, qb = it >> 3; isdiff = 1; bl = combo >> 2; head = combo & 3; qrow0 = bl * 8192 + qb * 256; }
        else if (it < 768) { const int u = it - 256; const int combo = u & 15, qb = u >> 4; isdiff = 0; bl = combo >> 3; head = combo & 7; qrow0 = bl * 8192 + qb * 256; }
        else { const int u = it - 768; NT = 4;
            if (u < 8) { isdiff = 1; bl = u >> 2; head = u & 3; } else { const int v = u - 8; isdiff = 0; bl = v >> 3; head = v & 7; }
            qrow0 = LROWS + bl * 256; }
        if (isdiff) diff_unit(p, l, bl, head, qrow0, NT, lds); else gqa_unit(p, bl, head, qrow0, NT, lds);
    }
    phase_lru(p, l, 2, lds, (l * 2 + hb) * 2 + 1);
}

#define XB_TMO      128
#define XB_XCNT(j)  (256  + 64 * (j))
#define XB_XSUB(j)  (1280 + 64 * (j))
#define XB_XGEN(j)  (2304 + 64 * (j))
#define XB_TOP      3328
#define XB_TOPGEN   3392
#define XCD_BAR_WORDS 3456
#define XB_SPIN_CAP (1u << 18)

__device__ __forceinline__ unsigned xb_ld(unsigned* p)              { return __hip_atomic_load(p, __ATOMIC_RELAXED, __HIP_MEMORY_SCOPE_AGENT); }
__device__ __forceinline__ unsigned xb_add(unsigned* p, unsigned v) { return __hip_atomic_fetch_add(p, v, __ATOMIC_RELAXED, __HIP_MEMORY_SCOPE_AGENT); }
__device__ __forceinline__ unsigned xb_xcc_id() { return (unsigned)__builtin_amdgcn_s_getreg((3 << 11) | 20) & 0xFu; }
#define XB_SPIN(cond, bar) do { unsigned _sp = 0; while (cond) { __builtin_amdgcn_s_sleep(1); \
    if ((++_sp & 255u) == 0u) { if (xb_ld(&(bar)[XB_TMO])) break; if (_sp > XB_SPIN_CAP) { atomicAdd(&(bar)[XB_TMO], 1u); break; } } } } while (0)

struct XcdBarrier {
    unsigned* bar; unsigned x;
    volatile LAS unsigned* st;
};

__device__ __forceinline__ XcdBarrier xcd_barrier_post(unsigned* bar, volatile LAS unsigned* st) {
    XcdBarrier b; b.bar = bar; b.x = xb_xcc_id(); b.st = st;
    if (threadIdx.x == 0) (void)xb_add(&bar[XB_XCNT(b.x)], 1u);
    return b;
}
__device__ __forceinline__ void xcd_barrier_complete(unsigned* bar, unsigned x, unsigned& nloc, unsigned& nx) {
    const unsigned G = gridDim.x * gridDim.y * gridDim.z;
    unsigned sum, cnt, mine, sp = 0u;
    for (;;) {
        sum = 0u; cnt = 0u; mine = 0u;
#pragma unroll
        for (unsigned j = 0; j < 16; ++j) { const unsigned c = xb_ld(&bar[XB_XCNT(j)]); sum += c; cnt += (c > 0u) ? 1u : 0u; mine = (j == x) ? c : mine; }
        if (sum == G) break;
        __builtin_amdgcn_s_sleep(1);
        if ((++sp & 255u) == 0u) { if (xb_ld(&bar[XB_TMO])) break; if (sp > XB_SPIN_CAP) { atomicAdd(&bar[XB_TMO], 1u); break; } }
    }
    nloc = mine > 0u ? mine : 1u; nx = cnt > 0u ? cnt : 1u;
}

__device__ __forceinline__ void xcd_barrier(const XcdBarrier& b) {
    asm volatile("s_waitcnt vmcnt(0)" ::: "memory");
    __syncthreads();
    if (threadIdx.x == 0) {
        unsigned* bar = b.bar; const unsigned bx = xb_xcc_id();
        __builtin_amdgcn_s_waitcnt(0);
        unsigned nloc = b.st[0], nx = b.st[1];
        if (nloc == 0u) { xcd_barrier_complete(bar, bx, nloc, nx); b.st[0] = nloc; b.st[1] = nx; }
        const unsigned old = xb_add(&bar[XB_XSUB(bx)], 1u);
        const unsigned gen = old / nloc;
        if (old + 1u == (gen + 1u) * nloc) {
            __builtin_amdgcn_fence(__ATOMIC_RELEASE, "agent");
            asm volatile("s_waitcnt vmcnt(0)" ::: "memory");
            const unsigned og = xb_add(&bar[XB_TOP], 1u);
            const unsigned tg = og / nx;
            if (og + 1u == (tg + 1u) * nx) xb_add(&bar[XB_TOPGEN], 1u);
            else XB_SPIN(xb_ld(&bar[XB_TOPGEN]) == tg, bar);
            __builtin_amdgcn_fence(__ATOMIC_ACQUIRE, "agent");
            xb_add(&bar[XB_XGEN(bx)], 1u);
            asm volatile("s_waitcnt vmcnt(0)" ::: "memory");
        } else {
            XB_SPIN(xb_ld(&bar[XB_XGEN(bx)]) == gen, bar);
            __builtin_amdgcn_fence(__ATOMIC_ACQUIRE, "agent");
            asm volatile("s_waitcnt vmcnt(0)" ::: "memory");
        }
    }
    __syncthreads();
}

constexpr int N_PHASES = 32;
__device__ __forceinline__ void run_phase(KP p, int ph, ldsp lds) {
    unsigned char* ws = p->ws;
    if (ph == N_PHASES - 1) { phase_final(p); return; }
    const int q = ph - 1, l = q / 15, s = q - l * 15;
    if (s == 0) { phase_norm(p, l, 0); return; }
    if (s == 12) { phase_norm(p, l, 1); return; }
    if (s >= 1 && s <= 10) {
        const int hb = (s - 1) / 5, k = (s - 1) - hb * 5;
        if (k == 0) {
            g8::Desc g{}; g.A0 = ws + WS_H + (size_t)hb * HROWS * DM * 2; g.B0 = ws + WS_WIN + (size_t)l * NIN * DM * 2; g.lda = DM; g.ldb = DM; g.nt = DM / 64; g.nseg = 1; g.nM = HROWS / 256; g.nN = NIN / 256; g.skipctx = 0;
            g8::EpiIn E{(bf16_t*)(ws + WS_Z), (bf16_t*)(ws + WS_G), p->b_gate + (size_t)l * GW};
            g8::gemm_phase(lds, g, E);
        } else if (k == 1) phase_post(p, l, hb, lds);
        else if (k == 2) phase_carry(p, lds);
        else if (k == 3) phase_mix(p, l, hb, lds);
        else {
            g8::Desc g{}; const unsigned char* zb = ws + WS_Z;
            g.A0 = zb + 512 * 2; g.dA = 512 * 2; g.dA2 = 256 * 2;
            g.B0 = ws + WS_WBR + (size_t)(l * 3) * DM * 512 * 2; g.dB = DM * 512 * 2;
            g.lda = ZW; g.ldb = 512; g.nt = 8; g.nseg = 3; g.nM = (l == 0) ? 66 : 64; g.nN = 4; g.skipctx = 0;
            g8::EpiMerge E{(const bf16_t*)(ws + WS_G), (bf16_t*)(ws + WS_H), hb * HROWS};
            g8::gemm_phase(lds, g, E);
        }
        return;
    }
    g8::Desc g{}; g.nseg = 1; g.nM = (l == 0) ? 132 : 128; g.skipctx = (l == 0) ? 0 : 1;
    if (s == 11) {
        g.A0 = ws + WS_H; g.B0 = ws + WS_WOUT + (size_t)l * DM * DM * 2; g.lda = DM; g.ldb = DM; g.nt = DM / 64; g.nN = 4;
        const float* modl = (const float*)(ws + WS_MOD) + (size_t)l * 5 * 6144;
        if (l == 0) { g8::EpiRes<true> E{p->x, p->ctx, (bf16_t*)(ws + WS_XS), modl, 2 * DM, nullptr}; g8::gemm_phase(lds, g, E); }
        else { g8::EpiRes<false> E{nullptr, nullptr, (bf16_t*)(ws + WS_XS), modl, 2 * DM, nullptr}; g8::gemm_phase(lds, g, E); }
    } else if (s == 13) {
        g.A0 = ws + WS_H; g.B0 = ws + WS_WUP + (size_t)l * FF * DM * 2; g.lda = DM; g.ldb = DM; g.nt = DM / 64; g.nN = FF / 256;
        g8::EpiUp E{(bf16_t*)(ws + WS_Z)};
        g8::gemm_phase(lds, g, E);
    } else {
        g.A0 = ws + WS_Z; g.B0 = ws + WS_WDN + (size_t)l * DM * FF * 2; g.lda = FF; g.ldb = FF; g.nt = FF / 64; g.nN = 4;
        const float* modl = (const float*)(ws + WS_MOD) + (size_t)l * 5 * 6144;
        if (l == 0) { g.nM = 128; g.skipctx = 1; g.xsplit = 8; }
        g8::EpiRes<false> E{nullptr, nullptr, (bf16_t*)(ws + WS_XS), modl, 5 * DM, (float*)(ws + WS_KD)};
        g8::gemm_phase(lds, g, E);
    }
}

__global__ void __launch_bounds__(512, 2) mega(Params pk, int ph_lo, int ph_hi) {
    extern __shared__ __attribute__((aligned(16))) unsigned char smem[];
    const ldsp lds = (ldsp)smem;
    volatile LAS unsigned* bst = (volatile LAS unsigned*)(lds + LDS_BYTES - 16);
    if (threadIdx.x < 2) bst[threadIdx.x] = 0u;
    __syncthreads();
    XcdBarrier bar; bar.bar = (unsigned*)pk.ws; bar.x = 0; bar.st = bst;
    int ph0 = ph_lo;
    if (ph_lo == 0) {
        if (blockIdx.x == 0) { unsigned* cw = (unsigned*)pk.ws;
            for (int i = threadIdx.x; i < (int)(WS_BAR_BYTES / 4); i += 512) __hip_atomic_store(cw + i, 0u, __ATOMIC_RELAXED, __HIP_MEMORY_SCOPE_AGENT); }
        KP p = (KP)__builtin_amdgcn_kernarg_segment_ptr();
        asm volatile("" : "+s"(p));
        phase_prologue(p, lds);
        if (ph_hi > 1) { cg::this_grid().sync(); bar = xcd_barrier_post((unsigned*)pk.ws, bst); }
        ph0 = 1;
    }
    for (int ph = ph0; ph < ph_hi; ++ph) {
        KP p = (KP)__builtin_amdgcn_kernarg_segment_ptr();
        asm volatile("" : "+s"(p));
        run_phase(p, ph, lds);
        if (ph + 1 < ph_hi) xcd_barrier(bar);
    }
}

extern "C" void kernel_launch(void* const* d_in, const int* in_sizes, int n_in, void* d_out, int out_size, void* d_ws, size_t ws_size, hipStream_t stream) {
    static int grid = 0;
    if (grid == 0) {
        if (ws_size < WS_END) { fprintf(stderr, "kernel_launch: workspace too small: %zu < %zu\n", ws_size, (size_t)WS_END); grid = -1; return; }
        int dev = 0, cus = 0, per_cu = 0;
        hipGetDevice(&dev); hipDeviceGetAttribute(&cus, hipDeviceAttributeMultiprocessorCount, dev);
        if (hipFuncSetAttribute((const void*)mega, hipFuncAttributeMaxDynamicSharedMemorySize, LDS_BYTES) != hipSuccess) { fprintf(stderr, "kernel_launch: hipFuncSetAttribute failed\n"); grid = -1; return; }
        if (hipOccupancyMaxActiveBlocksPerMultiprocessor(&per_cu, (const void*)mega, 512, LDS_BYTES) != hipSuccess || per_cu < 1) { fprintf(stderr, "kernel_launch: occupancy query gave %d\n", per_cu); per_cu = 1; }
        (void)hipGetLastError();
        grid = cus * 1;
        if (grid > 256) grid = 256;
    }
    if (grid < 0) return;
    Params hp{};
    const float** f = (const float**)&hp;
    for (int i = 0; i < 29; ++i) f[i] = (const float*)d_in[i];
    hp.out = (float*)d_out; hp.ws = (unsigned char*)d_ws;
#if N_LAUNCH_MODE == 1
    int lo = 0, hi = N_PHASES;
    void* args[] = {&hp, &lo, &hi};
    hipError_t e = hipLaunchCooperativeKernel((const void*)mega, dim3(grid), dim3(512), args, LDS_BYTES, stream);
    if (e != hipSuccess) fprintf(stderr, "cooperative launch failed: %s (grid %d)\n", hipGetErrorString(e), grid);
#else
    for (int ph = 0; ph < N_PHASES; ++ph) mega<<<dim3(grid), dim3(512), LDS_BYTES, stream>>>(hp, ph, ph + 1);
#endif
}
```

```cpp
#include <hip/hip_runtime.h>
#include <hip/hip_cooperative_groups.h>
#include <cstdio>
#include <cstdint>
namespace cg = cooperative_groups;

#ifndef N_LAUNCH_MODE
#define N_LAUNCH_MODE 1
#endif

#define LAS __attribute__((address_space(3)))
typedef LAS unsigned char* ldsp;
typedef unsigned short bf16_t;
typedef short bf16x8 __attribute__((ext_vector_type(8)));
typedef float f32x2 __attribute__((ext_vector_type(2)));
typedef float f32x4 __attribute__((ext_vector_type(4)));
typedef float f32x16 __attribute__((ext_vector_type(16)));
typedef unsigned u32x2 __attribute__((ext_vector_type(2)));
typedef unsigned u32x4 __attribute__((ext_vector_type(4)));
typedef __bf16 bf16x2_t __attribute__((ext_vector_type(2)));

constexpr int DM = 1024, NBATCH = 4, SEQ = 8192, CTX = 256, NIN = 6400, ZW = 3328, GW = 3072, FF = 4096;
constexpr int HROWS = 16896, LROWS = 16384, MROWS = 33792;
constexpr int NKT = 132;
constexpr int NCH = 132;
constexpr float EPS = 1e-6f;
constexpr float QSCALE = 0.125f * 1.4426950408889634f;
constexpr int LDS_BYTES = 139264;

constexpr size_t al256(size_t x) { return (x + 255) & ~(size_t)255; }
constexpr size_t WS_BAR = 0, WS_BAR_BYTES = 16384;
constexpr size_t WS_MOD = 16384;
constexpr size_t WS_LAM = al256(WS_MOD + 2 * 5 * 6144 * 4);
constexpr size_t WS_ROPE = al256(WS_LAM + 256);
constexpr size_t WS_WIN = al256(WS_ROPE + (size_t)8192 * 32 * 8);
constexpr size_t WS_WBR = al256(WS_WIN + (size_t)2 * NIN * DM * 2);
constexpr size_t WS_WOUT = al256(WS_WBR + (size_t)6 * DM * 512 * 2);
constexpr size_t WS_WUP = al256(WS_WOUT + (size_t)2 * DM * DM * 2);
constexpr size_t WS_WDN = al256(WS_WUP + (size_t)2 * FF * DM * 2);
constexpr size_t WS_XS = al256(WS_WDN + (size_t)2 * FF * DM * 2);
constexpr size_t WS_H = al256(WS_XS + (size_t)MROWS * DM * 2);
constexpr size_t WS_Z = al256(WS_H + (size_t)MROWS * DM * 2);
constexpr size_t WS_G = al256(WS_Z + (size_t)HROWS * ZW * 2);
constexpr size_t WS_KG = al256(WS_Z + (size_t)MROWS * FF * 2);
constexpr size_t WS_VG = al256(WS_KG + (size_t)4 * NKT * 8192);
constexpr size_t WS_KD = al256(WS_VG + (size_t)4 * NKT * 8192);
constexpr size_t WS_VD = al256(WS_KD + (size_t)16 * NKT * 8192);
constexpr size_t WS_SUM = al256(WS_VD + (size_t)8 * NKT * 16384);
constexpr size_t WS_ST = al256(WS_SUM + (size_t)2 * NCH * 2 * 512 * 8);
constexpr size_t WS_END = al256(WS_ST + (size_t)2 * NCH * 2 * 512 * 4);
static_assert(WS_G + (size_t)HROWS * GW * 2 <= WS_KG, "g inside the Z region");
static_assert(WS_VD == WS_KD + (size_t)16 * NKT * 8192 && (size_t)128 * 65536 * 4 <= (size_t)16 * NKT * 8192 + (size_t)8 * NKT * 16384, "split-K slabs overlay the (dead) diff K/V images");
static_assert(WS_END <= (size_t)536870912, "workspace map fits 512 MiB");

struct Params;
typedef const __attribute__((address_space(4))) Params* KP;
struct Params {
    const float *x, *c, *ctx, *c_ctx, *w_mod, *b_mod, *norm1_g, *w_in, *b_gate, *conv_w, *conv_b, *w_rg, *b_rg, *w_ig, *b_ig, *lru_lambda,
        *q_norm_g, *k_norm_g, *lq1, *lk1, *lq2, *lk2, *subln_g, *w_branch, *w_out, *norm2_g, *w_up, *w_down, *final_g;
    float* out;
    unsigned char* ws;
};

__device__ __forceinline__ unsigned pk2(float lo, float hi) { f32x2 v = {lo, hi}; bf16x2_t b = __builtin_convertvector(v, bf16x2_t); return __builtin_bit_cast(unsigned, b); }
__device__ __forceinline__ float bflo(unsigned w) { return __uint_as_float(w << 16); }
__device__ __forceinline__ float bfhi(unsigned w) { return __uint_as_float(w & 0xffff0000u); }
__device__ __forceinline__ float bf2f(bf16_t h) { return __uint_as_float(((unsigned)h) << 16); }
__device__ __forceinline__ float sigmoidf_(float v) { return __builtin_amdgcn_rcpf(1.0f + __builtin_amdgcn_exp2f(-1.4426950408889634f * v)); }
__device__ __forceinline__ float wave_sum(float v) {
#pragma unroll
    for (int o = 1; o < 64; o <<= 1) v += __shfl_xor(v, o);
    return v;
}
__device__ __forceinline__ int tid_() { int t = threadIdx.x; asm volatile("" : "+v"(t)); return t; }
__device__ __forceinline__ float lam_init_of(int l) { return l == 0 ? 0.2f : (0.8f - 0.6f * 0.74081822068171786607f); }

struct RowMap { const float* src; int modrow; };
__device__ __forceinline__ RowMap rowmap(KP p, int R) {
    const int hb = R / HROWS, lr = R - hb * HROWS;
    RowMap m;
    if (lr < LROWS) { const size_t li = (size_t)hb * LROWS + lr; m.src = p->x + li * DM; m.modrow = 2 * hb + (lr >> 13); }
    else { const size_t ci = (size_t)hb * 512 + (lr - LROWS); m.src = p->ctx + ci * DM; m.modrow = 4; }
    return m;
}

namespace g8 {
constexpr int BM = 256, BK = 64, HALF = 128, HTB = HALF * BK * 2;
__device__ __forceinline__ int lds_byte(int r, int c) { const int st = (r >> 4) * 2 + (c >> 5), rr = r & 15, cc = c & 31, ob = rr * 64 + cc * 2; return st * 1024 + (ob ^ (((ob >> 9) & 1) << 5)); }
__device__ __forceinline__ void stage_rc(int b, int& R, int& C) { const int st = b / 1024, sb = b % 1024, swz = sb ^ (((sb >> 9) & 1) << 5); R = (st >> 1) * 16 + swz / 64; C = (st & 1) * 32 + (swz % 64) / 2; }
__device__ __forceinline__ int perm32(int rho) { const int n = rho >> 4, i = rho & 15; return 8 * (i >> 2) + 4 * n + (i & 3); }

struct Desc { const unsigned char *A0, *B0; int lda, ldb, nt, nseg, nM, nN, skipctx, dA, dA2, dB, xsplit; };
struct Leg { const unsigned char* A; const unsigned char* B; int R0, c0, seg, nt, slab; };

__device__ __forceinline__ bool get_leg(const Desc& g, int i, Leg& l) {
    const int ui = i / g.nseg, seg = i - ui * g.nseg;
    const int nwg = g.nM * g.nN; const long L = (long)ui * gridDim.x + blockIdx.x;
    if (L >= nwg) {
        const int x = (int)(L - nwg); if (x >= 4 * g.nN * g.xsplit) return false;
        const int ks = x % g.xsplit, t_ = x / g.xsplit, pn = t_ % g.nN, j = t_ / g.nN; const int pm = (j >> 1) * 66 + 64 + (j & 1);
        const int ntk = g.nt / g.xsplit;
        l.A = g.A0 + (size_t)pm * 256 * g.lda * 2 + (size_t)ks * ntk * 128; l.B = g.B0 + (size_t)pn * 256 * g.ldb * 2 + (size_t)ks * ntk * 128;
        l.R0 = pm * 256; l.c0 = pn * 256; l.seg = 0; l.nt = ntk; l.slab = (j * g.nN + pn) * g.xsplit + ks; return true;
    }
    int wgid = (int)L; { const int q = nwg / 8, r = nwg % 8, xcd = wgid % 8, off = wgid / 8; wgid = (xcd < r ? xcd * (q + 1) : r * (q + 1) + (xcd - r) * q) + off; }
    const int nig = 8 * g.nN, gid = wgid / nig, fm = gid * 8, gsz = (g.nM - fm) < 8 ? (g.nM - fm) : 8;
    int pm = fm + ((wgid % nig) % gsz); const int pn = (wgid % nig) / gsz;
    if (g.skipctx) pm += 2 * (pm >> 6);
    l.A = g.A0 + (size_t)pm * 256 * g.lda * 2 + seg * g.dA + (seg >> 1) * g.dA2; l.B = g.B0 + (size_t)pn * 256 * g.ldb * 2 + (size_t)seg * g.dB; l.R0 = pm * 256; l.c0 = pn * 256; l.seg = seg; l.nt = g.nt; l.slab = -1;
    return true;
}

template <class Epi>
__device__ __forceinline__ void gemm_phase(ldsp lds, const Desc& g, const Epi& E) {
    const int tid = tid_(), wid = __builtin_amdgcn_readfirstlane(tid >> 6), lane = tid & 63, wr = wid >> 2, wc = wid & 3, fr = lane & 15, fq = lane >> 4;
    unsigned voffA, voffB;
    { int R, C; stage_rc(tid * 16, R, C); const int Rb = (R & ~31) + perm32(R & 31);
        voffA = (unsigned)(R * g.lda + C) * 2u; voffB = (unsigned)(Rb * g.ldb + C) * 2u; }
    const size_t p2offA = (size_t)64 * g.lda * 2, p2offB = (size_t)64 * g.ldb * 2; const unsigned vooffA = voffA, vooffB = voffB;
    const size_t kstep = (size_t)(BK * 2);
    const size_t hstepA = (size_t)HALF * g.lda * 2, hstepB = (size_t)HALF * g.ldb * 2;
    const unsigned ldsw = (unsigned)wid * 1024u;
    const int aoff = lds_byte(wr * 64 + fr, fq * 8), boff = lds_byte(wc * 32 + fr, fq * 8);
#define G8_SA(b, h) (((b) * 2 + (h)) * HTB)
#define G8_SB(b, h) ((4 + (b) * 2 + (h)) * HTB)
#define G8_STAGE(bufoff, gbase, voff) do { _Pragma("unroll") for (int _i = 0; _i < 2; ++_i) \
        __builtin_amdgcn_global_load_lds((const unsigned*)((const unsigned char*)(gbase) + (size_t)_i * p2##voff + vo##voff), (LAS unsigned*)(lds + (bufoff) + ldsw + _i * 8192), 16, 0, 0); } while (0)
#define G8_LDA(dst, b, h) do { _Pragma("unroll") for (int m = 0; m < 4; ++m) _Pragma("unroll") for (int k = 0; k < 2; ++k) dst[m][k] = *(const LAS bf16x8*)(lds + G8_SA(b, h) + aoff + m * 2048 + k * 1024); } while (0)
#define G8_LDB(dst, b, h) do { _Pragma("unroll") for (int n = 0; n < 2; ++n) _Pragma("unroll") for (int k = 0; k < 2; ++k) dst[n][k] = *(const LAS bf16x8*)(lds + G8_SB(b, h) + boff + n * 2048 + k * 1024); } while (0)
#define G8_MMA(ai, bj, At, Bt) do { __builtin_amdgcn_s_setprio(1); _Pragma("unroll") for (int m = 0; m < 4; ++m) _Pragma("unroll") for (int n = 0; n < 2; ++n) _Pragma("unroll") for (int k = 0; k < 2; ++k) \
        acc[ai][bj][m][n] = __builtin_amdgcn_mfma_f32_16x16x32_bf16(Bt[n][k], At[m][k], acc[ai][bj][m][n], 0, 0, 0); __builtin_amdgcn_s_setprio(0); } while (0)
#define G8_WAIT_V(n) asm volatile("s_waitcnt vmcnt(" #n ")" ::: "memory")
#define G8_WAIT_L(n) asm volatile("s_waitcnt lgkmcnt(" #n ")" ::: "memory")
#define G8_BAR __builtin_amdgcn_s_barrier()
#define G8_SCHED __builtin_amdgcn_sched_barrier(0)
#define G8_ZERO() do { _Pragma("unroll") for (int a = 0; a < 2; ++a) _Pragma("unroll") for (int b = 0; b < 2; ++b) _Pragma("unroll") for (int m = 0; m < 4; ++m) _Pragma("unroll") for (int n = 0; n < 2; ++n) acc[a][b][m][n] = (f32x4){0.f, 0.f, 0.f, 0.f}; } while (0)
    Leg cur, nxt; int ui = 0;
    if (!get_leg(g, 0, cur)) return;
    f32x4 acc[2][2][4][2];
    G8_ZERO();
    bf16x8 At[4][2], B0[2][2], B1[2][2];
    const unsigned char* cA = cur.A; const unsigned char* cB = cur.B;
    G8_STAGE(G8_SB(0, 0), cB, offB); G8_STAGE(G8_SB(0, 1), cB + hstepB, offB); G8_STAGE(G8_SA(0, 0), cA, offA); G8_STAGE(G8_SA(0, 1), cA + hstepA, offA);
    if (wr == 1) G8_BAR;
    G8_WAIT_V(2); G8_BAR;
    G8_STAGE(G8_SB(1, 0), cB + kstep, offB); G8_STAGE(G8_SA(1, 0), cA + kstep, offA); G8_STAGE(G8_SB(1, 1), cB + hstepB + kstep, offB);
    G8_WAIT_V(6); G8_BAR;
    for (;;) {
        const bool has_next = get_leg(g, ui + 1, nxt);
        const unsigned char* nA = has_next ? nxt.A : cA; const unsigned char* nB = has_next ? nxt.B : cB;
        const int nt = cur.nt;
        for (int t = 0; t < nt; t += 2) {
            const bool last = (t == nt - 2);
            const unsigned char* a1 = cA + (size_t)(t + 1) * kstep;
            const unsigned char* a2 = last ? nA : cA + (size_t)(t + 2) * kstep; const unsigned char* b2 = last ? nB : cB + (size_t)(t + 2) * kstep;
            const unsigned char* a3 = a2 + kstep; const unsigned char* b3 = b2 + kstep;
            G8_LDB(B0, 0, 0); G8_LDB(B1, 0, 1); G8_SCHED; G8_LDA(At, 0, 0); G8_STAGE(G8_SA(1, 1), a1 + hstepA, offA);
            G8_WAIT_V(8); G8_WAIT_L(0); G8_BAR; G8_MMA(0, 0, At, B0); G8_MMA(0, 1, At, B1); G8_BAR; G8_SCHED;
            G8_LDA(At, 0, 1); G8_STAGE(G8_SB(0, 0), b2, offB); G8_STAGE(G8_SB(0, 1), b2 + hstepB, offB); G8_STAGE(G8_SA(0, 0), a2, offA);
            G8_WAIT_V(8); G8_WAIT_L(0); G8_BAR; G8_MMA(1, 0, At, B0); G8_MMA(1, 1, At, B1); G8_BAR; G8_SCHED;
            G8_LDB(B0, 1, 0); G8_LDB(B1, 1, 1); G8_SCHED; G8_LDA(At, 1, 0); G8_STAGE(G8_SA(0, 1), a2 + hstepA, offA);
            G8_WAIT_V(8); G8_WAIT_L(0); G8_BAR; G8_MMA(0, 0, At, B0); G8_MMA(0, 1, At, B1); G8_BAR; G8_SCHED;
            G8_LDA(At, 1, 1); G8_STAGE(G8_SB(1, 0), b3, offB); G8_STAGE(G8_SB(1, 1), b3 + hstepB, offB); G8_STAGE(G8_SA(1, 0), a3, offA);
            G8_WAIT_V(8); G8_WAIT_L(0); G8_BAR; G8_MMA(1, 0, At, B0); G8_MMA(1, 1, At, B1); G8_BAR; G8_SCHED;
        }
        if (wr == 0) G8_BAR;
        E(acc, cur, wr, wc, fr, fq);
        if (!has_next) break;
        if (cur.seg == g.nseg - 1) G8_ZERO();
        cur = nxt; cA = nA; cB = nB; ++ui;
        if (wr == 1) G8_BAR;
    }
    G8_WAIT_V(0);
    G8_BAR;
#undef G8_SA
#undef G8_SB
#undef G8_STAGE
#undef G8_LDA
#undef G8_LDB
#undef G8_MMA
#undef G8_WAIT_V
#undef G8_WAIT_L
#undef G8_BAR
#undef G8_SCHED
#undef G8_ZERO
}

#define EPI_LOOP_BEGIN \
    _Pragma("unroll") for (int ai = 0; ai < 2; ++ai) _Pragma("unroll") for (int m = 0; m < 4; ++m) { const int row = l.R0 + ai * 128 + wr * 64 + m * 16 + fr; \
    _Pragma("unroll") for (int bj = 0; bj < 2; ++bj) { const int col = l.c0 + bj * 128 + wc * 32 + 8 * fq; f32x4 v0 = acc[ai][bj][m][0], v1 = acc[ai][bj][m][1];
#define EPI_LOOP_END __builtin_amdgcn_sched_barrier(0); } }

struct EpiIn {
    bf16_t* z; bf16_t* g; const float* bgate;
    __device__ __forceinline__ void operator()(f32x4 (&acc)[2][2][4][2], const Leg& l, int wr, int wc, int fr, int fq) const {
        EPI_LOOP_BEGIN
            if (l.c0 + bj * 128 < ZW) {
                u32x4 w; w.x = pk2(v0[0], v0[1]); w.y = pk2(v0[2], v0[3]); w.z = pk2(v1[0], v1[1]); w.w = pk2(v1[2], v1[3]);
                *(u32x4*)(z + (size_t)row * ZW + col) = w;
            } else {
                const int cg_ = col - ZW; const f32x4 b0 = *(const f32x4*)(bgate + cg_), b1 = *(const f32x4*)(bgate + cg_ + 4);
                u32x4 w; w.x = pk2(sigmoidf_(v0[0] + b0[0]), sigmoidf_(v0[1] + b0[1])); w.y = pk2(sigmoidf_(v0[2] + b0[2]), sigmoidf_(v0[3] + b0[3]));
                w.z = pk2(sigmoidf_(v1[0] + b1[0]), sigmoidf_(v1[1] + b1[1])); w.w = pk2(sigmoidf_(v1[2] + b1[2]), sigmoidf_(v1[3] + b1[3]));
                *(u32x4*)(g + (size_t)row * GW + cg_) = w;
            }
        EPI_LOOP_END
    }
};
struct EpiMerge {
    const bf16_t* g; bf16_t* H; int hrow0;
    __device__ __forceinline__ void operator()(f32x4 (&acc)[2][2][4][2], const Leg& l, int wr, int wc, int fr, int fq) const {
        EPI_LOOP_BEGIN
            const bf16_t* gp = g + (size_t)row * GW + col;
            const u32x4 ga = *(const u32x4*)(gp + l.seg * 1024);
            float f[8] = {bflo(ga.x), bfhi(ga.x), bflo(ga.y), bfhi(ga.y), bflo(ga.z), bfhi(ga.z), bflo(ga.w), bfhi(ga.w)};
            if (l.seg < 2) {
                const u32x4 gb = *(const u32x4*)(gp + (l.seg + 1) * 1024);
                const float d[8] = {bflo(gb.x), bfhi(gb.x), bflo(gb.y), bfhi(gb.y), bflo(gb.z), bfhi(gb.z), bflo(gb.w), bfhi(gb.w)};
#pragma unroll
                for (int e = 0; e < 8; ++e) f[e] = f[e] * __builtin_amdgcn_rcpf(d[e]);
                acc[ai][bj][m][0] = (f32x4){v0[0] * f[0], v0[1] * f[1], v0[2] * f[2], v0[3] * f[3]};
                acc[ai][bj][m][1] = (f32x4){v1[0] * f[4], v1[1] * f[5], v1[2] * f[6], v1[3] * f[7]};
            } else {
                u32x4 w; w.x = pk2(v0[0] * f[0], v0[1] * f[1]); w.y = pk2(v0[2] * f[2], v0[3] * f[3]); w.z = pk2(v1[0] * f[4], v1[1] * f[5]); w.w = pk2(v1[2] * f[6], v1[3] * f[7]);
                *(u32x4*)(H + (size_t)(hrow0 + row) * DM + col) = w;
            }
        EPI_LOOP_END
    }
};
template <bool F32SRC> struct EpiRes {
    const float* xin; const float* cin; bf16_t* S; const float* mod; int goff; float* slabs;
    __device__ __forceinline__ void operator()(f32x4 (&acc)[2][2][4][2], const Leg& l, int wr, int wc, int fr, int fq) const {
        const int hb = l.R0 / HROWS, lr = l.R0 - hb * HROWS;
        const float* src = nullptr; int modrow;
        if (lr < LROWS) { const size_t li = (size_t)hb * LROWS + lr; if (F32SRC) src = xin + li * DM; modrow = 2 * hb + (lr >> 13); }
        else { const size_t ci = (size_t)hb * 512 + (lr - LROWS); if (F32SRC) src = cin + ci * DM; modrow = 4; }
        const float* gate = mod + (size_t)modrow * 6144 + goff;
        if (l.slab >= 0) {
            float* sb = slabs + (size_t)l.slab * 65536;
            EPI_LOOP_BEGIN
                float* q = sb + (size_t)(row - l.R0) * 256 + (col - l.c0);
                *(f32x4*)q = v0; *(f32x4*)(q + 4) = v1;
            EPI_LOOP_END
            return;
        }
        EPI_LOOP_BEGIN
            bf16_t* dp = S + (size_t)row * DM + col;
            const f32x4 gv0 = *(const f32x4*)(gate + col), gv1 = *(const f32x4*)(gate + col + 4);
            f32x4 s0, s1;
            if (F32SRC) { const size_t o = (size_t)(row - l.R0) * DM + col; s0 = *(const f32x4*)(src + o); s1 = *(const f32x4*)(src + o + 4); }
            else { const u32x4 r_ = *(const u32x4*)dp; s0 = (f32x4){bflo(r_.x), bfhi(r_.x), bflo(r_.y), bfhi(r_.y)}; s1 = (f32x4){bflo(r_.z), bfhi(r_.z), bflo(r_.w), bfhi(r_.w)}; }
            const f32x4 y0 = s0 + gv0 * v0, y1 = s1 + gv1 * v1;
            u32x4 w; w.x = pk2(y0[0], y0[1]); w.y = pk2(y0[2], y0[3]); w.z = pk2(y1[0], y1[1]); w.w = pk2(y1[2], y1[3]);
            *(u32x4*)dp = w;
        EPI_LOOP_END
    }
};
struct EpiUp {
    bf16_t* a;
    __device__ __forceinline__ void operator()(f32x4 (&acc)[2][2][4][2], const Leg& l, int wr, int wc, int fr, int fq) const {
        EPI_LOOP_BEGIN
#pragma unroll
            for (int e = 0; e < 4; ++e) { const float a0 = fmaxf(v0[e], 0.f), a1 = fmaxf(v1[e], 0.f); v0[e] = a0 * a0; v1[e] = a1 * a1; }
            u32x4 w; w.x = pk2(v0[0], v0[1]); w.y = pk2(v0[2], v0[3]); w.z = pk2(v1[0], v1[1]); w.w = pk2(v1[2], v1[3]);
            *(u32x4*)(a + (size_t)row * FF + col) = w;
        EPI_LOOP_END
    }
};
}

__device__ __forceinline__ void transpose_tile(ldsp lds, const float* src, bf16_t* dst, int K, int N, int tk, int tn) {
    const int tid = tid_();
    LAS float* T = (LAS float*)lds;
#pragma unroll
    for (int i = 0; i < 2; ++i) {
        const int k = (tid >> 4) + i * 32, n4 = (tid & 15) * 4;
        const f32x4 v = *(const f32x4*)(src + (size_t)(tk * 64 + k) * N + tn * 64 + n4);
        T[k * 65 + n4] = v[0]; T[k * 65 + n4 + 1] = v[1]; T[k * 65 + n4 + 2] = v[2]; T[k * 65 + n4 + 3] = v[3];
    }
    __syncthreads();
    const int n = tid >> 3, k8 = (tid & 7) * 8;
    u32x4 w;
    w.x = pk2(T[(k8 + 0) * 65 + n], T[(k8 + 1) * 65 + n]); w.y = pk2(T[(k8 + 2) * 65 + n], T[(k8 + 3) * 65 + n]);
    w.z = pk2(T[(k8 + 4) * 65 + n], T[(k8 + 5) * 65 + n]); w.w = pk2(T[(k8 + 6) * 65 + n], T[(k8 + 7) * 65 + n]);
    *(u32x4*)(dst + (size_t)(tn * 64 + n) * K + tk * 64 + k8) = w;
    __syncthreads();
}

__device__ __forceinline__ void phase_prologue(KP p, ldsp lds) {
    const int tid = tid_(), G = gridDim.x;
    for (int it = blockIdx.x; it < 2 * 4288; it += G) {
        const int l = it / 4288; int r = it - l * 4288;
        const float* src; bf16_t* dst; int K, N;
        if (r < 1600) { src = p->w_in + (size_t)l * DM * NIN; dst = (bf16_t*)(p->ws + WS_WIN) + (size_t)l * NIN * DM; K = DM; N = NIN; }
        else if (r < 1984) { r -= 1600; const int n = r / 128; r -= n * 128; src = p->w_branch + (size_t)(l * 3 + n) * 512 * DM; dst = (bf16_t*)(p->ws + WS_WBR) + (size_t)(l * 3 + n) * DM * 512; K = 512; N = DM; }
        else if (r < 2240) { r -= 1984; src = p->w_out + (size_t)l * DM * DM; dst = (bf16_t*)(p->ws + WS_WOUT) + (size_t)l * DM * DM; K = DM; N = DM; }
        else if (r < 3264) { r -= 2240; src = p->w_up + (size_t)l * DM * FF; dst = (bf16_t*)(p->ws + WS_WUP) + (size_t)l * FF * DM; K = DM; N = FF; }
        else { r -= 3264; src = p->w_down + (size_t)l * FF * DM; dst = (bf16_t*)(p->ws + WS_WDN) + (size_t)l * DM * FF; K = FF; N = DM; }
        const int ntn = N / 64; const int tk = r / ntn, tn = r - tk * ntn;
        transpose_tile(lds, src, dst, K, N, tk, tn);
    }
    {
        LAS float* red = (LAS float*)lds;
        float* mod = (float*)(p->ws + WS_MOD);
        for (int it = blockIdx.x; it < 768; it += G) {
            const int j0 = it * 16, l = j0 / 6144, jj0 = j0 - l * 6144, jc = tid & 15, ks = tid >> 4;
            float a0 = 0.f, a1 = 0.f, a2 = 0.f, a3 = 0.f, a4 = 0.f;
            const float* wp = p->w_mod + ((size_t)l * DM + ks * 32) * 6144 + jj0 + jc;
#pragma unroll 8
            for (int i = 0; i < 32; ++i) {
                const int k = ks * 32 + i; const float w = wp[(size_t)i * 6144];
                const float c0 = p->c[k], c1 = p->c[DM + k], c2 = p->c[2 * DM + k], c3 = p->c[3 * DM + k], c4 = p->c_ctx[k];
                a0 += c0 * sigmoidf_(c0) * w; a1 += c1 * sigmoidf_(c1) * w; a2 += c2 * sigmoidf_(c2) * w; a3 += c3 * sigmoidf_(c3) * w; a4 += c4 * sigmoidf_(c4) * w;
            }
            red[(0 * 32 + ks) * 16 + jc] = a0; red[(1 * 32 + ks) * 16 + jc] = a1; red[(2 * 32 + ks) * 16 + jc] = a2; red[(3 * 32 + ks) * 16 + jc] = a3; red[(4 * 32 + ks) * 16 + jc] = a4;
            __syncthreads();
            if (tid < 80) { const int r = tid >> 4, c = tid & 15; float s = 0.f;
                for (int q = 0; q < 32; ++q) s += red[(r * 32 + q) * 16 + c];
                mod[((size_t)l * 5 + r) * 6144 + jj0 + c] = s + p->b_mod[(size_t)l * 6144 + jj0 + c]; }
            __syncthreads();
        }
    }
    {
        f32x2* cs = (f32x2*)(p->ws + WS_ROPE);
        for (int idx = blockIdx.x * 512 + tid; idx < 8192 * 32; idx += G * 512) {
            const int t = idx >> 5, e = idx & 31, axis = e >> 4, f = e & 15;
            const float pos = (float)(axis == 0 ? (t >> 6) : (t & 63));
            const float inv = powf(10000.0f, -(float)f * (1.0f / 16.0f));
            const float ang = pos * inv;
            cs[idx] = (f32x2){cosf(ang), sinf(ang)};
        }
    }
    if (blockIdx.x == 0 && tid < 128) {
        const int l = tid >> 6, e = tid & 63;
        const float s1 = wave_sum(p->lq1[l * 64 + e] * p->lk1[l * 64 + e]), s2 = wave_sum(p->lq2[l * 64 + e] * p->lk2[l * 64 + e]);
        if (e == 0) ((float*)(p->ws + WS_LAM))[l] = expf(s1) - expf(s2) + lam_init_of(l);
    }
}

__device__ __forceinline__ void phase_norm(KP p, int layer, int which) {
    const int tid = tid_(), lane = tid & 63, wv = tid >> 6;
    const float* ng = (which == 0 ? p->norm1_g : p->norm2_g) + (size_t)layer * DM;
    bf16_t* H = (bf16_t*)(p->ws + WS_H);
    const int stride = gridDim.x * 8;
    for (int R0 = blockIdx.x * 8 + wv; R0 < MROWS; R0 += 2 * stride) {
        f32x4 v[2][4]; const float* mod[2]; bool ok[2];
#pragma unroll
        for (int u = 0; u < 2; ++u) {
            const int R = R0 + u * stride; ok[u] = R < MROWS; mod[u] = nullptr;
            if (ok[u]) {
                const RowMap rm = rowmap(p, R);
                if (layer == 1 && which == 1 && rm.modrow == 4) { ok[u] = false; continue; }
                mod[u] = (const float*)(p->ws + WS_MOD) + ((size_t)layer * 5 + rm.modrow) * 6144 + (which == 0 ? 0 : 3 * DM);
                if (layer == 0 && which == 0) {
#pragma unroll
                    for (int k = 0; k < 4; ++k) v[u][k] = *(const f32x4*)(rm.src + k * 256 + lane * 4);
                } else {
                    const bf16_t* sp_ = (const bf16_t*)(p->ws + WS_XS) + (size_t)R * DM;
#pragma unroll
                    for (int k = 0; k < 4; ++k) { const u32x2 r_ = *(const u32x2*)(sp_ + k * 256 + lane * 4); v[u][k] = (f32x4){bflo(r_.x), bfhi(r_.x), bflo(r_.y), bfhi(r_.y)}; }
                }
                if (layer == 1 && which == 0 && rm.modrow == 4) {
                    const int hb_ = R / HROWS, c_ = R - hb_ * HROWS - LROWS, j_ = hb_ * 2 + (c_ >> 8), r_ = c_ & 255;
                    const float* g2 = (const float*)(p->ws + WS_MOD) + (size_t)4 * 6144 + 5 * DM;
                    const float* sb = (const float*)(p->ws + WS_KD) + (size_t)r_ * 256 + lane * 4;
#pragma unroll
                    for (int k = 0; k < 4; ++k) { f32x4 a = (f32x4){0.f, 0.f, 0.f, 0.f};
#pragma unroll
                        for (int ks = 0; ks < 8; ++ks) a += *(const f32x4*)(sb + (size_t)((j_ * 4 + k) * 8 + ks) * 65536);
                        v[u][k] += *(const f32x4*)(g2 + k * 256 + lane * 4) * a; }
                }
            }
        }
#pragma unroll
        for (int u = 0; u < 2; ++u) {
            if (!ok[u]) continue;
            const int R = R0 + u * stride;
            float ss = 0.f;
#pragma unroll
            for (int k = 0; k < 4; ++k) ss += v[u][k][0] * v[u][k][0] + v[u][k][1] * v[u][k][1] + v[u][k][2] * v[u][k][2] + v[u][k][3] * v[u][k][3];
            ss = wave_sum(ss);
            const float rstd = rsqrtf(ss * (1.0f / DM) + EPS);
#pragma unroll
            for (int k = 0; k < 4; ++k) {
                const int c = k * 256 + lane * 4;
                const f32x4 gg = *(const f32x4*)(ng + c), sh = *(const f32x4*)(mod[u] + c), sc = *(const f32x4*)(mod[u] + DM + c);
                float y[4];
#pragma unroll
                for (int e = 0; e < 4; ++e) y[e] = v[u][k][e] * rstd * gg[e] * (1.0f + sc[e]) + sh[e];
                u32x2 w; w.x = pk2(y[0], y[1]); w.y = pk2(y[2], y[3]);
                *(u32x2*)(H + (size_t)R * DM + c) = w;
            }
        }
    }
}

__device__ __forceinline__ void phase_final(KP p) {
    const int tid = tid_(), lane = tid & 63, wv = tid >> 6;
    const int stride = gridDim.x * 8;
    const bf16_t* S = (const bf16_t*)(p->ws + WS_XS);
    for (int r0 = blockIdx.x * 8 + wv; r0 < NBATCH * SEQ; r0 += 2 * stride) {
        f32x4 v[2][4];
#pragma unroll
        for (int u = 0; u < 2; ++u) { const int r = r0 + u * stride;
            if (r < NBATCH * SEQ) { const int hb = r >> 14; const bf16_t* sp_ = S + (size_t)(hb * HROWS + (r & (LROWS - 1))) * DM;
#pragma unroll
                for (int k = 0; k < 4; ++k) { const u32x2 r_ = *(const u32x2*)(sp_ + k * 256 + lane * 4); v[u][k] = (f32x4){bflo(r_.x), bfhi(r_.x), bflo(r_.y), bfhi(r_.y)}; } } }
#pragma unroll
        for (int u = 0; u < 2; ++u) { const int r = r0 + u * stride;
            if (r < NBATCH * SEQ) {
                float* row = p->out + (size_t)r * DM; float ss = 0.f;
#pragma unroll
                for (int k = 0; k < 4; ++k) ss += v[u][k][0] * v[u][k][0] + v[u][k][1] * v[u][k][1] + v[u][k][2] * v[u][k][2] + v[u][k][3] * v[u][k][3];
                ss = wave_sum(ss);
                const float rstd = rsqrtf(ss * (1.0f / DM) + EPS);
#pragma unroll
                for (int k = 0; k < 4; ++k) { const int c = k * 256 + lane * 4; const f32x4 gg = *(const f32x4*)(p->final_g + c); *(f32x4*)(row + c) = v[u][k] * rstd * gg; }
            } }
    }
}

__device__ __forceinline__ void post_item(KP p, int l, int item, ldsp lds) {
    const int tid = tid_();
    const int lr0 = item * 32;
    const bool isctx = lr0 >= LROWS;
    int bl, t0;
    if (!isctx) { bl = lr0 >> 13; t0 = lr0 & 8191; } else { const int c = lr0 - LROWS; bl = c >> 8; t0 = c & 255; }
    const int j0 = isctx ? t0 : 256 + t0;
    const int tile = j0 >> 6, kv0 = j0 & 63;
    bf16_t* z = (bf16_t*)(p->ws + WS_Z);
    const f32x2* cs = (const f32x2*)(p->ws + WS_ROPE);
    {
        const int row = (tid >> 3) & 31, g = tid & 7, sh = tid >> 8;
        const int axis = g >> 2, half = (g >> 1) & 1, f0 = (g & 1) * 8;
        bf16_t* rowp = z + (size_t)(lr0 + row) * ZW + g * 8;
        u32x4 raw[13];
#pragma unroll
        for (int it = 0; it < 13; ++it) {
            const int slot0 = 2 * it; const int colb = slot0 < 8 ? 1024 + slot0 * 64 : slot0 < 10 ? 1536 + (slot0 - 8) * 64 : slot0 < 18 ? 1792 + (slot0 - 10) * 64 : 2304 + (slot0 - 18) * 64;
            raw[it] = *(const u32x4*)(rowp + colb + sh * 64);
        }
        f32x2 cs8[8]; float gq[8], gk[8];
        if (!isctx) { const f32x2* cp = cs + (size_t)(t0 + row) * 32 + axis * 16 + f0;
#pragma unroll
            for (int e = 0; e < 8; ++e) cs8[e] = cp[e]; }
        else {
#pragma unroll
            for (int e = 0; e < 8; ++e) cs8[e] = (f32x2){1.f, 0.f}; }
#pragma unroll
        for (int e = 0; e < 8; ++e) { gq[e] = p->q_norm_g[l * 64 + g * 8 + e]; gk[e] = p->k_norm_g[l * 64 + g * 8 + e]; }
#pragma unroll
        for (int it = 0; it < 13; ++it) {
            const int slot0 = 2 * it; const int slot = slot0 + sh;
            const int colb = slot0 < 8 ? 1024 + slot0 * 64 : slot0 < 10 ? 1536 + (slot0 - 8) * 64 : slot0 < 18 ? 1792 + (slot0 - 10) * 64 : 2304 + (slot0 - 18) * 64;
            const u32x4 rw = raw[it];
            float x[8] = {bflo(rw.x), bfhi(rw.x), bflo(rw.y), bfhi(rw.y), bflo(rw.z), bfhi(rw.z), bflo(rw.w), bfhi(rw.w)};
            if (slot0 < 10) {
                float ss = 0.f;
#pragma unroll
                for (int e = 0; e < 8; ++e) ss += x[e] * x[e];
                ss += __shfl_xor(ss, 1); ss += __shfl_xor(ss, 2); ss += __shfl_xor(ss, 4);
                const float rstd = rsqrtf(ss * (1.0f / 64.0f) + EPS);
#pragma unroll
                for (int e = 0; e < 8; ++e) x[e] = x[e] * rstd * (slot0 < 8 ? gq[e] : gk[e]);
            }
            if (!isctx) {
#pragma unroll
                for (int e = 0; e < 8; ++e) {
                    const float o = __shfl_xor(x[e], 2); const f32x2 c = cs8[e];
                    x[e] = (half == 0) ? (x[e] * c[0] - o * c[1]) : (o * c[1] + x[e] * c[0]);
                }
            }
            const bool isq = (slot0 < 8) || (slot0 >= 10 && slot0 < 18);
            if (isq) {
#pragma unroll
                for (int e = 0; e < 8; ++e) x[e] *= QSCALE;
            }
            u32x4 w; w.x = pk2(x[0], x[1]); w.y = pk2(x[2], x[3]); w.z = pk2(x[4], x[5]); w.w = pk2(x[6], x[7]);
            if (isq) *(u32x4*)(rowp + colb + sh * 64) = w;
            else {
                const int kv = kv0 + row;
                unsigned char* dst = (slot0 < 10) ? p->ws + WS_KG + ((size_t)(bl * 2 + (slot - 8)) * NKT + tile) * 8192 : p->ws + WS_KD + ((size_t)(bl * 8 + (slot - 18)) * NKT + tile) * 8192;
                *(u32x4*)(dst + g * 1024 + kv * 16) = w;
            }
        }
    }
    {
        constexpr int PITCH = 1296;
        u32x4 vr[5];
#pragma unroll
        for (int i = 0; i < 5; ++i) {
            const int pc = i * 512 + tid; const int row = pc / 80, c8 = pc - row * 80;
            const int col = (c8 < 16) ? 1664 + c8 * 8 : 2816 + (c8 - 16) * 8;
            vr[i] = *(const u32x4*)(z + (size_t)(lr0 + row) * ZW + col);
        }
#pragma unroll
        for (int i = 0; i < 5; ++i) { const int pc = i * 512 + tid; const int row = pc / 80, c8 = pc - row * 80; *(LAS u32x4*)(lds + row * PITCH + c8 * 16) = vr[i]; }
        __syncthreads();
#pragma unroll
        for (int i = 0; i < 5; ++i) {
            const int task = i * 512 + tid; const int pp = task & 3, dcol = task >> 2;
            const int sl = pp >> 1, hi = pp & 1;
            unsigned short e[8];
#pragma unroll
            for (int q = 0; q < 8; ++q) { const int rr = 16 * sl + 8 * (q >> 2) + 4 * hi + (q & 3); e[q] = *(const LAS unsigned short*)(lds + rr * PITCH + dcol * 2); }
            u32x4 w; w.x = e[0] | ((unsigned)e[1] << 16); w.y = e[2] | ((unsigned)e[3] << 16); w.z = e[4] | ((unsigned)e[5] << 16); w.w = e[6] | ((unsigned)e[7] << 16);
            const int piece = (kv0 >> 3) + pp;
            unsigned char* dst; int d;
            if (dcol < 128) { const int kh = dcol >> 6; d = dcol & 63; dst = p->ws + WS_VG + ((size_t)(bl * 2 + kh) * NKT + tile) * 8192; }
            else { const int dc = dcol - 128, h = dc >> 7; d = dc & 127; dst = p->ws + WS_VD + ((size_t)(bl * 4 + h) * NKT + tile) * 16384; }
            *(u32x4*)(dst + d * 128 + ((piece ^ ((d >> 1) & 7)) * 16)) = w;
        }
        __syncthreads();
    }
}

constexpr int LRU_U = 0, LRU_W = 9216, LRU_AB = 46080, LRU_CP = 111616;
struct LruPre { u32x4 raw[4]; u32x4 gate; float st; };
struct LruItem { int nb, bl, ci, T, ts0, lrow0; };
__device__ __forceinline__ LruItem lru_decode(int item) {
    LruItem q; q.nb = item & 7; const int cidx = item >> 3; q.bl = cidx / NCH; q.ci = cidx - q.bl * NCH;
    const bool isctx = q.ci < 4; q.T = isctx ? CTX : SEQ; q.ts0 = isctx ? q.ci * 64 : (q.ci - 4) * 64;
    q.lrow0 = isctx ? LROWS + q.bl * 256 + q.ts0 : q.bl * 8192 + q.ts0; return q;
}
__device__ __forceinline__ void lru_prefetch(KP p, int item, int pass, int tid, LruPre& q) {
    const LruItem I = lru_decode(item);
    const bf16_t* z = (const bf16_t*)(p->ws + WS_Z);
    const int tok = tid >> 3, ch = I.nb * 64 + (tid & 7) * 8;
#pragma unroll
    for (int j = 0; j < 4; ++j) { const int ts = I.ts0 + tok + j - 2; u32x4 v = (u32x4){0u, 0u, 0u, 0u};
        if (ts >= 0 && ts < I.T) v = *(const u32x4*)(z + (size_t)(I.lrow0 + tok + j - 2) * ZW + ch);
        q.raw[j] = v; }
    if (pass == 2) {
        q.gate = *(const u32x4*)(z + (size_t)(I.lrow0 + tok) * ZW + 512 + ch);
        q.st = ((const float*)(p->ws + WS_ST))[(((size_t)I.bl * NCH + I.ci) * 2 + (tid >> 8)) * 512 + I.nb * 64 + (tid & 63)];
    }
}
__device__ __forceinline__ float fast_sigmoid(float v) { return __builtin_amdgcn_rcpf(1.0f + __builtin_amdgcn_exp2f(-1.4426950408889634f * v)); }

__device__ __forceinline__ void phase_lru(KP p, int l, int pass, ldsp lds, int qidx) {
    const int tid = tid_(), lane = tid & 63, wid = tid >> 6;
    constexpr int NPER = 2 * NCH;
    const int nbq = blockIdx.x & 7;
    unsigned* ctr = (unsigned*)p->ws + 3700 + qidx * 8 + nbq;
    volatile LAS int* tk = (volatile LAS int*)(lds + LDS_BYTES - 48);
    if (tid == 0) { tk[0] = (int)__hip_atomic_fetch_add(ctr, 1u, __ATOMIC_RELAXED, __HIP_MEMORY_SCOPE_AGENT); tk[1] = (int)__hip_atomic_fetch_add(ctr, 1u, __ATOMIC_RELAXED, __HIP_MEMORY_SCOPE_AGENT); }
    __syncthreads();
    int tcur = __builtin_amdgcn_readfirstlane(tk[0]), tnxt = __builtin_amdgcn_readfirstlane(tk[1]);
    __syncthreads();
    if (tcur >= NPER) return;
    int it = tcur * 8 + nbq;
    bf16_t* z = (bf16_t*)(p->ws + WS_Z);
    LruPre cur, nxt; lru_prefetch(p, it, pass, tid, cur);
    int cached_nb = -1;
    float cw[4][8], cb[8], brg = 0.f, big = 0.f, sp = 0.f;
    const int tok1 = tid >> 3, c8 = tid & 7;
    const int dir = wid >> 2, th = (wid >> 1) & 1, nt_ = wid & 1, r32 = lane & 31, hi = lane >> 5, chl = nt_ * 32 + r32;
    const int sdir = tid >> 8, ssub = (tid >> 6) & 3, sch = tid & 63;
    for (;;) {
        int tnn = NPER;
        if (tid == 0 && tnxt < NPER) tnn = (int)__hip_atomic_fetch_add(ctr, 1u, __ATOMIC_RELAXED, __HIP_MEMORY_SCOPE_AGENT);
        const LruItem I = lru_decode(it); const int nb = I.nb;
        if (cached_nb != nb) {
            for (int e = tid; e < 4 * 4096; e += 512) {
                const int mat = e >> 12, k = (e >> 6) & 63, n = e & 63; const int d_ = mat >> 1;
                const float* W = ((mat & 1) ? p->w_ig : p->w_rg) + ((((size_t)l * 2 + d_) * 8 + nb) * 64 + k) * 64 + n;
                *(LAS unsigned short*)(lds + LRU_W + (mat * 64 + n) * 144 + k * 2) = (unsigned short)(pk2(*W, 0.f) & 0xffffu);
            }
            const int ch = nb * 64 + c8 * 8;
#pragma unroll
            for (int j = 0; j < 4; ++j) { const f32x4 w0 = *(const f32x4*)(p->conv_w + ((size_t)l * 4 + j) * 512 + ch), w1 = *(const f32x4*)(p->conv_w + ((size_t)l * 4 + j) * 512 + ch + 4);
                cw[j][0] = w0[0]; cw[j][1] = w0[1]; cw[j][2] = w0[2]; cw[j][3] = w0[3]; cw[j][4] = w1[0]; cw[j][5] = w1[1]; cw[j][6] = w1[2]; cw[j][7] = w1[3]; }
            { const f32x4 b0 = *(const f32x4*)(p->conv_b + (size_t)l * 512 + ch), b1 = *(const f32x4*)(p->conv_b + (size_t)l * 512 + ch + 4);
              cb[0] = b0[0]; cb[1] = b0[1]; cb[2] = b0[2]; cb[3] = b0[3]; cb[4] = b1[0]; cb[5] = b1[1]; cb[6] = b1[2]; cb[7] = b1[3]; }
            const size_t pi = ((size_t)l * 2 + dir) * 512 + nb * 64 + chl;
            brg = p->b_rg[pi]; big = p->b_ig[pi];
            const float lamv = p->lru_lambda[pi];
            { const float xe = __expf(-lamv);
              const float ser = xe * (1.0f - xe * (0.5f - xe * ((1.0f / 3.0f) - xe * 0.25f)));
              sp = (lamv < -20.f) ? -lamv : ((xe < 0.03f) ? ser : __logf(1.0f + xe)); }
            cached_nb = nb;
        }
        if (tnxt < NPER) lru_prefetch(p, tnxt * 8 + nbq, pass, tid, nxt);
        {
            float a[8];
#pragma unroll
            for (int e = 0; e < 8; ++e) a[e] = cb[e];
#pragma unroll
            for (int j = 0; j < 4; ++j) { const u32x4 raw = cur.raw[j];
                a[0] += bflo(raw.x) * cw[j][0]; a[1] += bfhi(raw.x) * cw[j][1]; a[2] += bflo(raw.y) * cw[j][2]; a[3] += bfhi(raw.y) * cw[j][3];
                a[4] += bflo(raw.z) * cw[j][4]; a[5] += bfhi(raw.z) * cw[j][5]; a[6] += bflo(raw.w) * cw[j][6]; a[7] += bfhi(raw.w) * cw[j][7]; }
            u32x4 w; w.x = pk2(a[0], a[1]); w.y = pk2(a[2], a[3]); w.z = pk2(a[4], a[5]); w.w = pk2(a[6], a[7]);
            *(LAS u32x4*)(lds + LRU_U + tok1 * 144 + c8 * 16) = w;
        }
        __syncthreads();
        {
            f32x16 ar = {}, aig = {};
#pragma unroll
            for (int ks = 0; ks < 4; ++ks) {
                const bf16x8 a = *(const LAS bf16x8*)(lds + LRU_U + (th * 32 + r32) * 144 + (2 * ks + hi) * 16);
                const bf16x8 br = *(const LAS bf16x8*)(lds + LRU_W + ((dir * 2 + 0) * 64 + nt_ * 32 + r32) * 144 + (2 * ks + hi) * 16);
                const bf16x8 bi = *(const LAS bf16x8*)(lds + LRU_W + ((dir * 2 + 1) * 64 + nt_ * 32 + r32) * 144 + (2 * ks + hi) * 16);
                ar = __builtin_amdgcn_mfma_f32_32x32x16_bf16(a, br, ar, 0, 0, 0);
                aig = __builtin_amdgcn_mfma_f32_32x32x16_bf16(a, bi, aig, 0, 0, 0);
            }
#pragma unroll
            for (int r = 0; r < 16; ++r) {
                const int tok = th * 32 + (r & 3) + 8 * (r >> 2) + 4 * hi;
                const float rg = fast_sigmoid(ar[r] + brg), ig = fast_sigmoid(aig[r] + big);
                const float log_a = -8.0f * rg * sp;
                const float av = __builtin_amdgcn_exp2f(1.4426950408889634f * log_a);
                const float x = 2.0f * log_a;
                const float poly = -x * (1.0f + x * 0.5f * (1.0f + x * (1.0f / 3.0f) * (1.0f + x * 0.25f * (1.0f + x * 0.2f))));
                const float em = (x > -0.25f) ? poly : (1.0f - av * av);
                const float uu = bf2f(*(const LAS unsigned short*)(lds + LRU_U + tok * 144 + chl * 2));
                const float bv = __builtin_amdgcn_sqrtf(fmaxf(em, 0.f)) * (ig * uu);
                *(LAS f32x2*)(lds + LRU_AB + ((dir * 64 + tok) * 64 + chl) * 8) = (f32x2){av, bv};
            }
        }
        if (tid == 0) tk[0] = tnn;
        __syncthreads();
        const int tnn_all = __builtin_amdgcn_readfirstlane(tk[0]);
        {
            float A = 1.f, B = 0.f;
#pragma unroll
            for (int i = 0; i < 16; ++i) {
                const int tok = ssub * 16 + (sdir == 0 ? i : 15 - i);
                const f32x2 ab = *(const LAS f32x2*)(lds + LRU_AB + ((sdir * 64 + tok) * 64 + sch) * 8);
                B = ab[0] * B + ab[1]; A = ab[0] * A;
            }
            *(LAS f32x2*)(lds + LRU_CP + ((sdir * 4 + ssub) * 64 + sch) * 8) = (f32x2){A, B};
        }
        __syncthreads();
        if (pass == 1) {
            if (ssub == 0) {
                float A = 1.f, B = 0.f;
#pragma unroll
                for (int i = 0; i < 4; ++i) {
                    const int s_ = (sdir == 0) ? i : 3 - i;
                    const f32x2 cp = *(const LAS f32x2*)(lds + LRU_CP + ((sdir * 4 + s_) * 64 + sch) * 8);
                    B = cp[0] * B + cp[1]; A = cp[0] * A;
                }
                ((f32x2*)(p->ws + WS_SUM))[(((size_t)I.bl * NCH + I.ci) * 2 + sdir) * 512 + nb * 64 + sch] = (f32x2){A, B};
            }
        } else {
            {
                float h = cur.st;
#pragma unroll
                for (int i = 0; i < 3; ++i) {
                    const int s_ = (sdir == 0) ? i : 3 - i;
                    const bool before = (sdir == 0) ? (s_ < ssub) : (s_ > ssub);
                    const f32x2 cp = *(const LAS f32x2*)(lds + LRU_CP + ((sdir * 4 + s_) * 64 + sch) * 8);
                    if (before) h = cp[0] * h + cp[1];
                }
#pragma unroll
                for (int i = 0; i < 16; ++i) {
                    const int tok = ssub * 16 + (sdir == 0 ? i : 15 - i);
                    LAS f32x2* q = (LAS f32x2*)(lds + LRU_AB + ((sdir * 64 + tok) * 64 + sch) * 8);
                    const f32x2 ab = *q;
                    h = ab[0] * h + ab[1];
                    (*q)[0] = h;
                }
            }
            __syncthreads();
            {
                bf16_t* gp = z + (size_t)(I.lrow0 + tok1) * ZW + 512 + nb * 64 + c8 * 8;
                const u32x4 raw = cur.gate;
                const float gt[8] = {bflo(raw.x), bfhi(raw.x), bflo(raw.y), bfhi(raw.y), bflo(raw.z), bfhi(raw.z), bflo(raw.w), bfhi(raw.w)};
                float y[8];
#pragma unroll
                for (int e = 0; e < 8; ++e) {
                    const float hf = (*(const LAS f32x2*)(lds + LRU_AB + ((0 * 64 + tok1) * 64 + c8 * 8 + e) * 8))[0];
                    const float hb_ = (*(const LAS f32x2*)(lds + LRU_AB + ((1 * 64 + tok1) * 64 + c8 * 8 + e) * 8))[0];
                    const float v = gt[e];
                    const float inner = 0.7978845608028654f * (v + 0.044715f * v * v * v);
                    const float th_ = 1.0f - 2.0f * __builtin_amdgcn_rcpf(1.0f + __builtin_amdgcn_exp2f(2.885390081777927f * inner));
                    y[e] = (hf + hb_) * (0.5f * v * (1.0f + th_));
                }
                u32x4 w; w.x = pk2(y[0], y[1]); w.y = pk2(y[2], y[3]); w.z = pk2(y[4], y[5]); w.w = pk2(y[6], y[7]);
                *(u32x4*)gp = w;
            }
        }
        if (tnxt >= NPER) break;
        cur = nxt; it = tnxt * 8 + nbq; tnxt = tnn_all;
    }
    __syncthreads();
}

__device__ __forceinline__ void carry_item(KP p, int item, ldsp lds) {
    const int tid = tid_();
    const int bl = item >> 4, dir = (item >> 3) & 1, nb = item & 7;
    const f32x2* sum = (const f32x2*)(p->ws + WS_SUM);
    float* st = (float*)(p->ws + WS_ST);
    for (int e = tid; e < NCH * 64; e += 512) { const int ci = e >> 6, ch = e & 63;
        *(LAS f32x2*)(lds + e * 8) = sum[(((size_t)bl * NCH + ci) * 2 + dir) * 512 + nb * 64 + ch]; }
    __syncthreads();
    if (tid < 64) {
        float h = 0.f;
        for (int i = 0; i < NCH; ++i) {
            int ci;
            if (dir == 0) ci = i; else ci = (i < 4) ? 3 - i : (NCH - 1) - (i - 4);
            st[(((size_t)bl * NCH + ci) * 2 + dir) * 512 + nb * 64 + tid] = h;
            const f32x2 ab = *(const LAS f32x2*)(lds + (ci * 64 + tid) * 8);
            h = ab[0] * h + ab[1];
        }
    }
    __syncthreads();
}

template <int DV>
__device__ __forceinline__ void attn_pass(ldsp lds, const bf16x8 (&qr)[4], const unsigned char* Kt, const unsigned char* Vt, int NT, f32x16 (&o)[DV / 32], float& lsum) {
    constexpr int VB = DV * 128, NV = DV / 64, VOFF = 24576;
    const int tid = tid_(), lane = tid & 63, r32 = lane & 31, hi = lane >> 5;
    const int wid = __builtin_amdgcn_readfirstlane(tid >> 6);
    const unsigned char* ksrc = Kt + tid * 16; const unsigned char* vsrc = Vt + tid * 16;
    const ldsp kdst = lds + wid * 1024, vdst = lds + VOFF + wid * 1024;
#define ATT_LOAD(t, buf) do { __builtin_amdgcn_global_load_lds((const unsigned*)(ksrc + (size_t)(t) * 8192), (LAS unsigned*)(kdst + (buf) * 8192), 16, 0, 0); \
        _Pragma("unroll") for (int i = 0; i < NV; ++i) __builtin_amdgcn_global_load_lds((const unsigned*)(vsrc + (size_t)(t) * VB + i * 8192), (LAS unsigned*)(vdst + (buf) * VB + i * 8192), 16, 0, 0); } while (0)
    ATT_LOAD(0, 0);
    if (NT > 1) ATT_LOAD(1, 1);
    if (NT > 1) { if (DV == 64) asm volatile("s_waitcnt vmcnt(2)" ::: "memory"); else asm volatile("s_waitcnt vmcnt(3)" ::: "memory"); }
    else asm volatile("s_waitcnt vmcnt(0)" ::: "memory");
    __builtin_amdgcn_s_barrier();
    f32x16 osum = (f32x16){};
    bf16x8 ones; { const short one = (r32 == 0) ? (short)0x3F80 : (short)0; ones = (bf16x8){one, one, one, one, one, one, one, one}; }
    float mref = 0.f, lacc = 0.f;
    f32x16 negm = (f32x16){};
#pragma unroll
    for (int d = 0; d < DV / 32; ++d) o[d] = (f32x16){};
    const int kfo = hi * 1024 + r32 * 16, vfo = r32 * 128, vx = (r32 >> 1) & 7;
    constexpr float THR = 8.0f;
    const float PINF = __builtin_inff();
    int cur = 0;
    for (int t = 0; t < NT; ++t) {
        const bool more2 = (t + 2 < NT);
        { const int nb2 = (cur == 0) ? 2 : cur - 1;
          if (more2) ATT_LOAD(t + 2, nb2); }
        const ldsp kb = lds + cur * 8192 + kfo;
        bf16x8 kf[8];
#pragma unroll
        for (int d0 = 0; d0 < 4; ++d0) { kf[2 * d0] = *(const LAS bf16x8*)(kb + d0 * 2048); kf[2 * d0 + 1] = *(const LAS bf16x8*)(kb + d0 * 2048 + 512); }
        __builtin_amdgcn_sched_barrier(0);
        f32x16 p0 = __builtin_amdgcn_mfma_f32_32x32x16_bf16(kf[0], qr[0], negm, 0, 0, 0);
        f32x16 p1 = __builtin_amdgcn_mfma_f32_32x32x16_bf16(kf[1], qr[0], negm, 0, 0, 0);
#pragma unroll
        for (int d0 = 1; d0 < 4; ++d0) {
            p0 = __builtin_amdgcn_mfma_f32_32x32x16_bf16(kf[2 * d0], qr[d0], p0, 0, 0, 0);
            p1 = __builtin_amdgcn_mfma_f32_32x32x16_bf16(kf[2 * d0 + 1], qr[d0], p1, 0, 0, 0);
        }
        __builtin_amdgcn_sched_barrier(0);
        const ldsp vb = lds + VOFF + cur * VB + vfo;
        bf16x8 va[4], vc[4];
#pragma unroll
        for (int s = 0; s < 4; ++s) va[s] = *(const LAS bf16x8*)(vb + (((2 * s + hi) ^ vx) * 16));
        __builtin_amdgcn_sched_barrier(0);
        float m0 = __builtin_amdgcn_fmed3f(__builtin_amdgcn_fmed3f(p0[0], p0[1], PINF), p0[2], PINF), m1 = __builtin_amdgcn_fmed3f(__builtin_amdgcn_fmed3f(p1[0], p1[1], PINF), p1[2], PINF);
#pragma unroll
        for (int r = 3; r < 15; r += 2) {
            m0 = __builtin_amdgcn_fmed3f(__builtin_amdgcn_fmed3f(m0, p0[r], PINF), p0[r + 1], PINF);
            m1 = __builtin_amdgcn_fmed3f(__builtin_amdgcn_fmed3f(m1, p1[r], PINF), p1[r + 1], PINF);
        }
        float mx = __builtin_amdgcn_fmed3f(__builtin_amdgcn_fmed3f(m0, p0[15], PINF), __builtin_amdgcn_fmed3f(m1, p1[15], PINF), PINF);
        { auto rr = __builtin_amdgcn_permlane32_swap(__float_as_uint(mx), __float_as_uint(mx), false, false);
          mx = __builtin_amdgcn_fmed3f(__uint_as_float(rr[0]), __uint_as_float(rr[1]), PINF); }
        if (t == 0 || __any(mx > THR)) {
            const float dl = (t == 0) ? mx : fmaxf(mx, 0.f);
            const float f = (t == 0) ? 0.f : __builtin_amdgcn_exp2f(-dl);
            mref += dl; osum[0] *= f;
#pragma unroll
            for (int r = 0; r < 16; ++r) { p0[r] -= dl; p1[r] -= dl; negm[r] = -mref; }
            asm volatile("" : "+v"(negm));
#pragma unroll
            for (int d = 0; d < DV / 32; ++d)
#pragma unroll
                for (int r = 0; r < 16; ++r) o[d][r] *= f;
        }
        bf16x8 pb[4];
#pragma unroll
        for (int r = 0; r < 16; ++r) p0[r] = __builtin_amdgcn_exp2f(p0[r]);
        { u32x4 w;
          w.x = pk2(p0[0], p0[1]); w.y = pk2(p0[2], p0[3]); w.z = pk2(p0[4], p0[5]); w.w = pk2(p0[6], p0[7]); pb[0] = __builtin_bit_cast(bf16x8, w);
          w.x = pk2(p0[8], p0[9]); w.y = pk2(p0[10], p0[11]); w.z = pk2(p0[12], p0[13]); w.w = pk2(p0[14], p0[15]); pb[1] = __builtin_bit_cast(bf16x8, w); }
#pragma unroll
        for (int s = 0; s < 4; ++s) vc[s] = *(const LAS bf16x8*)(vb + 4096 + (((2 * s + hi) ^ vx) * 16));
        __builtin_amdgcn_sched_barrier(0);
#pragma unroll
        for (int s = 0; s < 2; ++s) {
            osum = __builtin_amdgcn_mfma_f32_32x32x16_bf16(ones, pb[s], osum, 0, 0, 0);
            o[0] = __builtin_amdgcn_mfma_f32_32x32x16_bf16(va[s], pb[s], o[0], 0, 0, 0);
            if (DV == 64) o[1] = __builtin_amdgcn_mfma_f32_32x32x16_bf16(vc[s], pb[s], o[1], 0, 0, 0);
        }
#pragma unroll
        for (int r = 0; r < 16; ++r) p1[r] = __builtin_amdgcn_exp2f(p1[r]);
        { u32x4 w;
          w.x = pk2(p1[0], p1[1]); w.y = pk2(p1[2], p1[3]); w.z = pk2(p1[4], p1[5]); w.w = pk2(p1[6], p1[7]); pb[2] = __builtin_bit_cast(bf16x8, w);
          w.x = pk2(p1[8], p1[9]); w.y = pk2(p1[10], p1[11]); w.z = pk2(p1[12], p1[13]); w.w = pk2(p1[14], p1[15]); pb[3] = __builtin_bit_cast(bf16x8, w); }
        if (DV == 64) {
#pragma unroll
            for (int i = 0; i < 6; ++i) { __builtin_amdgcn_sched_group_barrier(0x008, 1, 0); __builtin_amdgcn_sched_group_barrier(0x402, 4, 0); }
        } else {
#pragma unroll
            for (int i = 0; i < 4; ++i) { __builtin_amdgcn_sched_group_barrier(0x008, 1, 0); __builtin_amdgcn_sched_group_barrier(0x402, 6, 0); }
        }
        __builtin_amdgcn_sched_barrier(0);
#pragma unroll
        for (int s = 2; s < 4; ++s) {
            osum = __builtin_amdgcn_mfma_f32_32x32x16_bf16(ones, pb[s], osum, 0, 0, 0);
            o[0] = __builtin_amdgcn_mfma_f32_32x32x16_bf16(va[s], pb[s], o[0], 0, 0, 0);
            if (DV == 64) o[1] = __builtin_amdgcn_mfma_f32_32x32x16_bf16(vc[s], pb[s], o[1], 0, 0, 0);
        }
        if (DV == 128) {
#pragma unroll
            for (int d = 1; d < DV / 32; ++d) {
                if (d + 1 < DV / 32) {
#pragma unroll
                    for (int s = 0; s < 4; ++s) { const bf16x8 x = *(const LAS bf16x8*)(vb + (d + 1) * 4096 + (((2 * s + hi) ^ vx) * 16)); if (d & 1) va[s] = x; else vc[s] = x; }
                }
                __builtin_amdgcn_sched_barrier(0);
#pragma unroll
                for (int s = 0; s < 4; ++s) o[d] = __builtin_amdgcn_mfma_f32_32x32x16_bf16((d & 1) ? vc[s] : va[s], pb[s], o[d], 0, 0, 0);
                __builtin_amdgcn_sched_barrier(0);
            }
        }
        if (more2) { if (DV == 64) asm volatile("s_waitcnt vmcnt(2) lgkmcnt(0)" ::: "memory"); else asm volatile("s_waitcnt vmcnt(3) lgkmcnt(0)" ::: "memory"); }
        else asm volatile("s_waitcnt vmcnt(0) lgkmcnt(0)" ::: "memory");
        __builtin_amdgcn_s_barrier();
        cur = (cur == 2) ? 0 : cur + 1;
    }
#undef ATT_LOAD
    { const float l0 = (hi == 0) ? osum[0] : 0.f; (void)lacc;
      auto rr = __builtin_amdgcn_permlane32_swap(__float_as_uint(l0), __float_as_uint(l0), false, false); lsum = __uint_as_float(rr[0]) + __uint_as_float(rr[1]); }
}

__device__ __forceinline__ void gqa_unit(KP p, int bl, int head, int qrow0, int NT, ldsp lds) {
    const int tid = tid_(), lane = tid & 63, wid = tid >> 6, r32 = lane & 31, hi = lane >> 5;
    bf16_t* qp = (bf16_t*)(p->ws + WS_Z) + (size_t)(qrow0 + wid * 32 + r32) * ZW + 1024 + head * 64;
    bf16x8 qr[4];
#pragma unroll
    for (int d0 = 0; d0 < 4; ++d0) qr[d0] = *(const bf16x8*)(qp + d0 * 16 + hi * 8);
    const int kh = head >> 2;
    f32x16 o[2]; float ls;
    attn_pass<64>(lds, qr, p->ws + WS_KG + (size_t)(bl * 2 + kh) * NKT * 8192, p->ws + WS_VG + (size_t)(bl * 2 + kh) * NKT * 8192, NT, o, ls);
    const float inv = 1.0f / ls;
#pragma unroll
    for (int d = 0; d < 2; ++d)
#pragma unroll
        for (int g = 0; g < 4; ++g) {
            u32x2 w; w.x = pk2(o[d][4 * g] * inv, o[d][4 * g + 1] * inv); w.y = pk2(o[d][4 * g + 2] * inv, o[d][4 * g + 3] * inv);
            *(u32x2*)(qp + d * 32 + 8 * g + 4 * hi) = w;
        }
}

__device__ __forceinline__ void diff_unit(KP p, int l, int bl, int h, int qrow0, int NT, ldsp lds) {
    const int tid = tid_(), lane = tid & 63, wid = tid >> 6, r32 = lane & 31, hi = lane >> 5;
    bf16_t* qp = (bf16_t*)(p->ws + WS_Z) + (size_t)(qrow0 + wid * 32 + r32) * ZW + 1792 + h * 128;
    f32x4* stash = (f32x4*)(p->out + ((size_t)blockIdx.x * 512 + tid) * 64);
    const float lam = ((const float*)(p->ws + WS_LAM))[l];
    f32x16 o[4]; float ls;
    for (int j = 0; j < 2; ++j) {
        bf16x8 qr[4];
#pragma unroll
        for (int d0 = 0; d0 < 4; ++d0) qr[d0] = *(const bf16x8*)(qp + j * 64 + d0 * 16 + hi * 8);
        attn_pass<128>(lds, qr, p->ws + WS_KD + (size_t)(bl * 8 + 2 * h + j) * NKT * 8192, p->ws + WS_VD + (size_t)(bl * 4 + h) * NKT * 16384, NT, o, ls);
        const float inv = 1.0f / ls;
        if (j == 0) {
#pragma unroll
            for (int d = 0; d < 4; ++d)
#pragma unroll
                for (int g = 0; g < 4; ++g) stash[d * 4 + g] = (f32x4){o[d][4 * g] * inv, o[d][4 * g + 1] * inv, o[d][4 * g + 2] * inv, o[d][4 * g + 3] * inv};
        } else {
            float ss = 0.f;
#pragma unroll
            for (int d = 0; d < 4; ++d)
#pragma unroll
                for (int g = 0; g < 4; ++g) { const f32x4 s1 = stash[d * 4 + g];
#pragma unroll
                    for (int e = 0; e < 4; ++e) { const float v = s1[e] - lam * (o[d][4 * g + e] * inv); o[d][4 * g + e] = v; ss = __builtin_fmaf(v, v, ss); }
                    __builtin_amdgcn_sched_barrier(0); }
            ss += __shfl_xor(ss, 32);
            const float rstd = rsqrtf(ss * (1.0f / 128.0f) + EPS) * (1.0f - lam_init_of(l));
            const float* sg = p->subln_g + (size_t)l * 128;
#pragma unroll
            for (int d = 0; d < 4; ++d)
#pragma unroll
                for (int g = 0; g < 4; ++g) {
                    const int dd = d * 32 + 8 * g + 4 * hi;
                    const f32x4 gg = *(const f32x4*)(sg + dd);
                    u32x2 w; w.x = pk2(o[d][4 * g] * rstd * gg[0], o[d][4 * g + 1] * rstd * gg[1]); w.y = pk2(o[d][4 * g + 2] * rstd * gg[2], o[d][4 * g + 3] * rstd * gg[3]);
                    *(u32x2*)(qp + dd) = w;
                }
        }
    }
}

__device__ __forceinline__ void phase_post(KP p, int l, int hb, ldsp lds) {
    const int G = gridDim.x;
    for (int it = blockIdx.x; it < HROWS / 32; it += G) post_item(p, l, it, lds);
    phase_lru(p, l, 1, lds, (l * 2 + hb) * 2 + 0);
}
__device__ __forceinline__ void phase_carry(KP p, ldsp lds) {
    for (int it = blockIdx.x; it < 32; it += gridDim.x) carry_item(p, it, lds);
}
__device__ __forceinline__ void phase_mix(KP p, int l, int hb, ldsp lds) {
    const int G = gridDim.x;
    const int nctx = (l == 0) ? 24 : 0;
    const int total = 256 + 512 + nctx;
    int b0_ = blockIdx.x; asm volatile("" : "+s"(b0_));
    unsigned* cdone = (unsigned*)p->ws + 3900 + (l * 2 + hb) * 16;
    for (int it = b0_; it < 32; it += G) {
        carry_item(p, it, lds);
        asm volatile("s_waitcnt vmcnt(0)" ::: "memory");
        __syncthreads();
        if (threadIdx.x == 0) { __builtin_amdgcn_fence(__ATOMIC_RELEASE, "agent"); asm volatile("s_waitcnt vmcnt(0)" ::: "memory");
            __hip_atomic_fetch_add(cdone, 1u, __ATOMIC_RELAXED, __HIP_MEMORY_SCOPE_AGENT); }
    }
    for (int it = b0_; it < total; it += G) {
        int isdiff, bl, head, qrow0, NT = NKT;
        if (it < 256) { const int combo = it & 7, qb = it >> 3; isdiff = 1; bl = combo >> 2; head = combo & 3; qrow0 = bl * 8192 + qb * 256; }
        else if (it < 768) { const int u = it - 256; const int combo = u & 15, qb = u >> 4; isdiff = 0; bl = combo >> 3; head = combo & 7; qrow0 = bl * 8192 + qb * 256; }
        else { const int u = it - 768; NT = 4;
            if (u < 8) { isdiff = 1; bl = u >> 2; head = u & 3; } else { const int v = u - 8; isdiff = 0; bl = v >> 3; head = v & 7; }
            qrow0 = LROWS + bl * 256; }
        if (isdiff) diff_unit(p, l, bl, head, qrow0, NT, lds); else gqa_unit(p, bl, head, qrow0, NT, lds);
    }
    if (threadIdx.x == 0) {
        unsigned sp_ = 0;
        while (__hip_atomic_load(cdone, __ATOMIC_RELAXED, __HIP_MEMORY_SCOPE_AGENT) < 32u) { __builtin_amdgcn_s_sleep(8); if (++sp_ > (1u << 20)) break; }
        __builtin_amdgcn_fence(__ATOMIC_ACQUIRE, "agent"); asm volatile("s_waitcnt vmcnt(0)" ::: "memory");
    }
    __syncthreads();
    phase_lru(p, l, 2, lds, (l * 2 + hb) * 2 + 1);
}

#define XB_TMO      128
#define XB_XCNT(j)  (256  + 64 * (j))
#define XB_XSUB(j)  (1280 + 64 * (j))
#define XB_XGEN(j)  (2304 + 64 * (j))
#define XB_TOP      3328
#define XB_TOPGEN   3392
#define XCD_BAR_WORDS 3456
#define XB_SPIN_CAP (1u << 18)

__device__ __forceinline__ unsigned xb_ld(unsigned* p)              { return __hip_atomic_load(p, __ATOMIC_RELAXED, __HIP_MEMORY_SCOPE_AGENT); }
__device__ __forceinline__ unsigned xb_add(unsigned* p, unsigned v) { return __hip_atomic_fetch_add(p, v, __ATOMIC_RELAXED, __HIP_MEMORY_SCOPE_AGENT); }
__device__ __forceinline__ unsigned xb_xcc_id() { return (unsigned)__builtin_amdgcn_s_getreg((3 << 11) | 20) & 0xFu; }
#define XB_SPIN(cond, bar) do { unsigned _sp = 0; while (cond) { __builtin_amdgcn_s_sleep(1); \
    if ((++_sp & 255u) == 0u) { if (xb_ld(&(bar)[XB_TMO])) break; if (_sp > XB_SPIN_CAP) { atomicAdd(&(bar)[XB_TMO], 1u); break; } } } } while (0)

struct XcdBarrier {
    unsigned* bar; unsigned x;
    volatile LAS unsigned* st;
};

__device__ __forceinline__ XcdBarrier xcd_barrier_post(unsigned* bar, volatile LAS unsigned* st) {
    XcdBarrier b; b.bar = bar; b.x = xb_xcc_id(); b.st = st;
    if (threadIdx.x == 0) (void)xb_add(&bar[XB_XCNT(b.x)], 1u);
    return b;
}
__device__ __forceinline__ void xcd_barrier_complete(unsigned* bar, unsigned x, unsigned& nloc, unsigned& nx) {
    const unsigned G = gridDim.x * gridDim.y * gridDim.z;
    unsigned sum, cnt, mine, sp = 0u;
    for (;;) {
        sum = 0u; cnt = 0u; mine = 0u;
#pragma unroll
        for (unsigned j = 0; j < 16; ++j) { const unsigned c = xb_ld(&bar[XB_XCNT(j)]); sum += c; cnt += (c > 0u) ? 1u : 0u; mine = (j == x) ? c : mine; }
        if (sum == G) break;
        __builtin_amdgcn_s_sleep(1);
        if ((++sp & 255u) == 0u) { if (xb_ld(&bar[XB_TMO])) break; if (sp > XB_SPIN_CAP) { atomicAdd(&bar[XB_TMO], 1u); break; } }
    }
    nloc = mine > 0u ? mine : 1u; nx = cnt > 0u ? cnt : 1u;
}

__device__ __forceinline__ void xcd_barrier(const XcdBarrier& b) {
    asm volatile("s_waitcnt vmcnt(0)" ::: "memory");
    __syncthreads();
    if (threadIdx.x == 0) {
        unsigned* bar = b.bar; const unsigned bx = xb_xcc_id();
        __builtin_amdgcn_s_waitcnt(0);
        unsigned nloc = b.st[0], nx = b.st[1];
        if (nloc == 0u) { xcd_barrier_complete(bar, bx, nloc, nx); b.st[0] = nloc; b.st[1] = nx; }
        const unsigned old = xb_add(&bar[XB_XSUB(bx)], 1u);
        const unsigned gen = old / nloc;
        if (old + 1u == (gen + 1u) * nloc) {
            __builtin_amdgcn_fence(__ATOMIC_RELEASE, "agent");
            asm volatile("s_waitcnt vmcnt(0)" ::: "memory");
            const unsigned og = xb_add(&bar[XB_TOP], 1u);
            const unsigned tg = og / nx;
            if (og + 1u == (tg + 1u) * nx) xb_add(&bar[XB_TOPGEN], 1u);
            else XB_SPIN(xb_ld(&bar[XB_TOPGEN]) == tg, bar);
            __builtin_amdgcn_fence(__ATOMIC_ACQUIRE, "agent");
            xb_add(&bar[XB_XGEN(bx)], 1u);
            asm volatile("s_waitcnt vmcnt(0)" ::: "memory");
        } else {
            XB_SPIN(xb_ld(&bar[XB_XGEN(bx)]) == gen, bar);
            __builtin_amdgcn_fence(__ATOMIC_ACQUIRE, "agent");
            asm volatile("s_waitcnt vmcnt(0)" ::: "memory");
        }
    }
    __syncthreads();
}

constexpr int N_PHASES = 28;
__device__ __forceinline__ void run_phase(KP p, int ph, ldsp lds) {
    unsigned char* ws = p->ws;
    if (ph == N_PHASES - 1) { phase_final(p); return; }
    const int q = ph - 1, l = q / 13, s = q - l * 13;
    if (s == 0) { phase_norm(p, l, 0); return; }
    if (s == 10) { phase_norm(p, l, 1); return; }
    if (s >= 1 && s <= 8) {
        const int hb = (s - 1) / 4, k = (s - 1) - hb * 4;
        if (k == 0) {
            g8::Desc g{}; g.A0 = ws + WS_H + (size_t)hb * HROWS * DM * 2; g.B0 = ws + WS_WIN + (size_t)l * NIN * DM * 2; g.lda = DM; g.ldb = DM; g.nt = DM / 64; g.nseg = 1; g.nM = HROWS / 256; g.nN = NIN / 256; g.skipctx = 0;
            g8::EpiIn E{(bf16_t*)(ws + WS_Z), (bf16_t*)(ws + WS_G), p->b_gate + (size_t)l * GW};
            g8::gemm_phase(lds, g, E);
        } else if (k == 1) phase_post(p, l, hb, lds);
        else if (k == 2) phase_mix(p, l, hb, lds);
        else {
            g8::Desc g{}; const unsigned char* zb = ws + WS_Z;
            g.A0 = zb + 512 * 2; g.dA = 512 * 2; g.dA2 = 256 * 2;
            g.B0 = ws + WS_WBR + (size_t)(l * 3) * DM * 512 * 2; g.dB = DM * 512 * 2;
            g.lda = ZW; g.ldb = 512; g.nt = 8; g.nseg = 3; g.nM = (l == 0) ? 66 : 64; g.nN = 4; g.skipctx = 0;
            g8::EpiMerge E{(const bf16_t*)(ws + WS_G), (bf16_t*)(ws + WS_H), hb * HROWS};
            g8::gemm_phase(lds, g, E);
        }
        return;
    }
    g8::Desc g{}; g.nseg = 1; g.nM = (l == 0) ? 132 : 128; g.skipctx = (l == 0) ? 0 : 1;
    if (s == 9) {
        g.A0 = ws + WS_H; g.B0 = ws + WS_WOUT + (size_t)l * DM * DM * 2; g.lda = DM; g.ldb = DM; g.nt = DM / 64; g.nN = 4;
        const float* modl = (const float*)(ws + WS_MOD) + (size_t)l * 5 * 6144;
        if (l == 0) { g8::EpiRes<true> E{p->x, p->ctx, (bf16_t*)(ws + WS_XS), modl, 2 * DM, nullptr}; g8::gemm_phase(lds, g, E); }
        else { g8::EpiRes<false> E{nullptr, nullptr, (bf16_t*)(ws + WS_XS), modl, 2 * DM, nullptr}; g8::gemm_phase(lds, g, E); }
    } else if (s == 11) {
        g.A0 = ws + WS_H; g.B0 = ws + WS_WUP + (size_t)l * FF * DM * 2; g.lda = DM; g.ldb = DM; g.nt = DM / 64; g.nN = FF / 256;
        g8::EpiUp E{(bf16_t*)(ws + WS_Z)};
        g8::gemm_phase(lds, g, E);
    } else {
        g.A0 = ws + WS_Z; g.B0 = ws + WS_WDN + (size_t)l * DM * FF * 2; g.lda = FF; g.ldb = FF; g.nt = FF / 64; g.nN = 4;
        const float* modl = (const float*)(ws + WS_MOD) + (size_t)l * 5 * 6144;
        if (l == 0) { g.nM = 128; g.skipctx = 1; g.xsplit = 8; }
        g8::EpiRes<false> E{nullptr, nullptr, (bf16_t*)(ws + WS_XS), modl, 5 * DM, (float*)(ws + WS_KD)};
        g8::gemm_phase(lds, g, E);
    }
}

__global__ void __launch_bounds__(512, 2) mega(Params pk, int ph_lo, int ph_hi) {
    extern __shared__ __attribute__((aligned(16))) unsigned char smem[];
    const ldsp lds = (ldsp)smem;
    volatile LAS unsigned* bst = (volatile LAS unsigned*)(lds + LDS_BYTES - 16);
    if (threadIdx.x < 2) bst[threadIdx.x] = 0u;
    __syncthreads();
    XcdBarrier bar; bar.bar = (unsigned*)pk.ws; bar.x = 0; bar.st = bst;
    if (ph_hi - ph_lo > 1) bar = xcd_barrier_post((unsigned*)pk.ws, bst);
    int ph0 = ph_lo;
    if (ph_lo == 0) {
        KP p = (KP)__builtin_amdgcn_kernarg_segment_ptr();
        asm volatile("" : "+s"(p));
        phase_prologue(p, lds);
        if (ph_hi > 1) cg::this_grid().sync();
        ph0 = 1;
    }
    for (int ph = ph0; ph < ph_hi; ++ph) {
        KP p = (KP)__builtin_amdgcn_kernarg_segment_ptr();
        asm volatile("" : "+s"(p));
        run_phase(p, ph, lds);
        if (ph + 1 < ph_hi) xcd_barrier(bar);
    }
}

extern "C" void kernel_launch(void* const* d_in, const int* in_sizes, int n_in, void* d_out, int out_size, void* d_ws, size_t ws_size, hipStream_t stream) {
    static int grid = 0;
    if (grid == 0) {
        if (ws_size < WS_END) { fprintf(stderr, "kernel_launch: workspace too small: %zu < %zu\n", ws_size, (size_t)WS_END); grid = -1; return; }
        int dev = 0, cus = 0, per_cu = 0;
        hipGetDevice(&dev); hipDeviceGetAttribute(&cus, hipDeviceAttributeMultiprocessorCount, dev);
        if (hipFuncSetAttribute((const void*)mega, hipFuncAttributeMaxDynamicSharedMemorySize, LDS_BYTES) != hipSuccess) { fprintf(stderr, "kernel_launch: hipFuncSetAttribute failed\n"); grid = -1; return; }
        if (hipOccupancyMaxActiveBlocksPerMultiprocessor(&per_cu, (const void*)mega, 512, LDS_BYTES) != hipSuccess || per_cu < 1) { fprintf(stderr, "kernel_launch: occupancy query gave %d\n", per_cu); per_cu = 1; }
        (void)hipGetLastError();
        grid = cus * 1;
        if (grid > 256) grid = 256;
    }
    if (grid < 0) return;
    Params hp{};
    const float** f = (const float**)&hp;
    for (int i = 0; i < 29; ++i) f[i] = (const float*)d_in[i];
    hp.out = (float*)d_out; hp.ws = (unsigned char*)d_ws;
    if (hipMemsetAsync((char*)d_ws + WS_BAR, 0, WS_BAR_BYTES, stream) != hipSuccess) { fprintf(stderr, "kernel_launch: memset of the barrier words failed\n"); return; }
#if N_LAUNCH_MODE == 1
    int lo = 0, hi = N_PHASES;
    void* args[] = {&hp, &lo, &hi};
    hipError_t e = hipLaunchCooperativeKernel((const void*)mega, dim3(grid), dim3(512), args, LDS_BYTES, stream);
    if (e != hipSuccess) fprintf(stderr, "cooperative launch failed: %s (grid %d)\n", hipGetErrorString(e), grid);
#else
    for (int ph = 0; ph < N_PHASES; ++ph) mega<<<dim3(grid), dim3(512), LDS_BYTES, stream>>>(hp, ph, ph + 1);
#endif
}
```

```cpp
#include <hip/hip_runtime.h>
#include <hip/hip_cooperative_groups.h>
#include <cstdio>
#include <cstdint>
namespace cg = cooperative_groups;

#ifndef N_LAUNCH_MODE
#define N_LAUNCH_MODE 1
#endif

#define LAS __attribute__((address_space(3)))
typedef LAS unsigned char* ldsp;
typedef unsigned short bf16_t;
typedef short bf16x8 __attribute__((ext_vector_type(8)));
typedef float f32x2 __attribute__((ext_vector_type(2)));
typedef float f32x4 __attribute__((ext_vector_type(4)));
typedef float f32x16 __attribute__((ext_vector_type(16)));
typedef unsigned u32x2 __attribute__((ext_vector_type(2)));
typedef unsigned u32x4 __attribute__((ext_vector_type(4)));
typedef __bf16 bf16x2_t __attribute__((ext_vector_type(2)));

constexpr int DM = 1024, NBATCH = 4, SEQ = 8192, CTX = 256, NIN = 6400, ZW = 3328, GW = 3072, FF = 4096;
constexpr int HROWS = 16896, LROWS = 16384, MROWS = 33792;
constexpr int NKT = 132;
constexpr int NCH = 132;
constexpr float EPS = 1e-6f;
constexpr float QSCALE = 0.125f * 1.4426950408889634f;
constexpr int LDS_BYTES = 139264;

constexpr size_t al256(size_t x) { return (x + 255) & ~(size_t)255; }
constexpr size_t WS_BAR = 0, WS_BAR_BYTES = 16384;
constexpr size_t WS_MOD = 16384;
constexpr size_t WS_LAM = al256(WS_MOD + 2 * 5 * 6144 * 4);
constexpr size_t WS_ROPE = al256(WS_LAM + 256);
constexpr size_t WS_WIN = al256(WS_ROPE + (size_t)8192 * 32 * 8);
constexpr size_t WS_WBR = al256(WS_WIN + (size_t)2 * NIN * DM * 2);
constexpr size_t WS_WOUT = al256(WS_WBR + (size_t)6 * DM * 512 * 2);
constexpr size_t WS_WUP = al256(WS_WOUT + (size_t)2 * DM * DM * 2);
constexpr size_t WS_WDN = al256(WS_WUP + (size_t)2 * FF * DM * 2);
constexpr size_t WS_XS = al256(WS_WDN + (size_t)2 * FF * DM * 2);
constexpr size_t WS_H = al256(WS_XS + (size_t)MROWS * DM * 2);
constexpr size_t WS_Z = al256(WS_H + (size_t)MROWS * DM * 2);
constexpr size_t WS_G = al256(WS_Z + (size_t)HROWS * ZW * 2);
constexpr size_t WS_KG = al256(WS_Z + (size_t)MROWS * FF * 2);
constexpr size_t WS_VG = al256(WS_KG + (size_t)4 * NKT * 8192);
constexpr size_t WS_KD = al256(WS_VG + (size_t)4 * NKT * 8192);
constexpr size_t WS_VD = al256(WS_KD + (size_t)16 * NKT * 8192);
constexpr size_t WS_SUM = al256(WS_VD + (size_t)8 * NKT * 16384);
constexpr size_t WS_ST = al256(WS_SUM + (size_t)2 * NCH * 2 * 512 * 8);
constexpr size_t WS_END = al256(WS_ST + (size_t)2 * NCH * 2 * 512 * 4);
static_assert(WS_G + (size_t)HROWS * GW * 2 <= WS_KG, "g inside the Z region");
static_assert(WS_VD == WS_KD + (size_t)16 * NKT * 8192 && (size_t)128 * 65536 * 4 <= (size_t)16 * NKT * 8192 + (size_t)8 * NKT * 16384, "split-K slabs overlay the (dead) diff K/V images");
static_assert(WS_END <= (size_t)536870912, "workspace map fits 512 MiB");

struct Params;
typedef const __attribute__((address_space(4))) Params* KP;
struct Params {
    const float *x, *c, *ctx, *c_ctx, *w_mod, *b_mod, *norm1_g, *w_in, *b_gate, *conv_w, *conv_b, *w_rg, *b_rg, *w_ig, *b_ig, *lru_lambda,
        *q_norm_g, *k_norm_g, *lq1, *lk1, *lq2, *lk2, *subln_g, *w_branch, *w_out, *norm2_g, *w_up, *w_down, *final_g;
    float* out;
    unsigned char* ws;
};

__device__ __forceinline__ unsigned pk2(float lo, float hi) { f32x2 v = {lo, hi}; bf16x2_t b = __builtin_convertvector(v, bf16x2_t); return __builtin_bit_cast(unsigned, b); }
__device__ __forceinline__ float bflo(unsigned w) { return __uint_as_float(w << 16); }
__device__ __forceinline__ float bfhi(unsigned w) { return __uint_as_float(w & 0xffff0000u); }
__device__ __forceinline__ float bf2f(bf16_t h) { return __uint_as_float(((unsigned)h) << 16); }
__device__ __forceinline__ float sigmoidf_(float v) { return __builtin_amdgcn_rcpf(1.0f + __builtin_amdgcn_exp2f(-1.4426950408889634f * v)); }
__device__ __forceinline__ float wave_sum(float v) {
#pragma unroll
    for (int o = 1; o < 64; o <<= 1) v += __shfl_xor(v, o);
    return v;
}
__device__ __forceinline__ int tid_() { int t = threadIdx.x; asm volatile("" : "+v"(t)); return t; }
__device__ __forceinline__ float lam_init_of(int l) { return l == 0 ? 0.2f : (0.8f - 0.6f * 0.74081822068171786607f); }

struct RowMap { const float* src; int modrow; };
__device__ __forceinline__ RowMap rowmap(KP p, int R) {
    const int hb = R / HROWS, lr = R - hb * HROWS;
    RowMap m;
    if (lr < LROWS) { const size_t li = (size_t)hb * LROWS + lr; m.src = p->x + li * DM; m.modrow = 2 * hb + (lr >> 13); }
    else { const size_t ci = (size_t)hb * 512 + (lr - LROWS); m.src = p->ctx + ci * DM; m.modrow = 4; }
    return m;
}

namespace g8 {
constexpr int BM = 256, BK = 64, HALF = 128, HTB = HALF * BK * 2;
__device__ __forceinline__ int lds_byte(int r, int c) { const int st = (r >> 4) * 2 + (c >> 5), rr = r & 15, cc = c & 31, ob = rr * 64 + cc * 2; return st * 1024 + (ob ^ (((ob >> 9) & 1) << 5)); }
__device__ __forceinline__ void stage_rc(int b, int& R, int& C) { const int st = b / 1024, sb = b % 1024, swz = sb ^ (((sb >> 9) & 1) << 5); R = (st >> 1) * 16 + swz / 64; C = (st & 1) * 32 + (swz % 64) / 2; }
__device__ __forceinline__ int perm32(int rho) { const int n = rho >> 4, i = rho & 15; return 8 * (i >> 2) + 4 * n + (i & 3); }

struct Desc { const unsigned char *A0, *B0; int lda, ldb, nt, nseg, nM, nN, skipctx, dA, dA2, dB, xsplit; };
struct Leg { const unsigned char* A; const unsigned char* B; int R0, c0, seg, nt, slab; };

__device__ __forceinline__ bool get_leg(const Desc& g, int i, Leg& l) {
    const int ui = i / g.nseg, seg = i - ui * g.nseg;
    const int nwg = g.nM * g.nN; const long L = (long)ui * gridDim.x + blockIdx.x;
    if (L >= nwg) {
        const int x = (int)(L - nwg); if (x >= 4 * g.nN * g.xsplit) return false;
        const int ks = x % g.xsplit, t_ = x / g.xsplit, pn = t_ % g.nN, j = t_ / g.nN; const int pm = (j >> 1) * 66 + 64 + (j & 1);
        const int ntk = g.nt / g.xsplit;
        l.A = g.A0 + (size_t)pm * 256 * g.lda * 2 + (size_t)ks * ntk * 128; l.B = g.B0 + (size_t)pn * 256 * g.ldb * 2 + (size_t)ks * ntk * 128;
        l.R0 = pm * 256; l.c0 = pn * 256; l.seg = 0; l.nt = ntk; l.slab = (j * g.nN + pn) * g.xsplit + ks; return true;
    }
    int wgid = (int)L; { const int q = nwg / 8, r = nwg % 8, xcd = wgid % 8, off = wgid / 8; wgid = (xcd < r ? xcd * (q + 1) : r * (q + 1) + (xcd - r) * q) + off; }
    const int nig = 8 * g.nN, gid = wgid / nig, fm = gid * 8, gsz = (g.nM - fm) < 8 ? (g.nM - fm) : 8;
    int pm = fm + ((wgid % nig) % gsz); const int pn = (wgid % nig) / gsz;
    if (g.skipctx) pm += 2 * (pm >> 6);
    l.A = g.A0 + (size_t)pm * 256 * g.lda * 2 + seg * g.dA + (seg >> 1) * g.dA2; l.B = g.B0 + (size_t)pn * 256 * g.ldb * 2 + (size_t)seg * g.dB; l.R0 = pm * 256; l.c0 = pn * 256; l.seg = seg; l.nt = g.nt; l.slab = -1;
    return true;
}

template <class Epi>
__device__ __forceinline__ void gemm_phase(ldsp lds, const Desc& g, const Epi& E) {
    const int tid = tid_(), wid = __builtin_amdgcn_readfirstlane(tid >> 6), lane = tid & 63, wr = wid >> 2, wc = wid & 3, fr = lane & 15, fq = lane >> 4;
    unsigned voffA, voffB;
    { int R, C; stage_rc(tid * 16, R, C); const int Rb = (R & ~31) + perm32(R & 31);
        voffA = (unsigned)(R * g.lda + C) * 2u; voffB = (unsigned)(Rb * g.ldb + C) * 2u; }
    const size_t p2offA = (size_t)64 * g.lda * 2, p2offB = (size_t)64 * g.ldb * 2; const unsigned vooffA = voffA, vooffB = voffB;
    const size_t kstep = (size_t)(BK * 2);
    const size_t hstepA = (size_t)HALF * g.lda * 2, hstepB = (size_t)HALF * g.ldb * 2;
    const unsigned ldsw = (unsigned)wid * 1024u;
    const int aoff = lds_byte(wr * 64 + fr, fq * 8), boff = lds_byte(wc * 32 + fr, fq * 8);
#define G8_SA(b, h) (((b) * 2 + (h)) * HTB)
#define G8_SB(b, h) ((4 + (b) * 2 + (h)) * HTB)
#define G8_STAGE(bufoff, gbase, voff) do { _Pragma("unroll") for (int _i = 0; _i < 2; ++_i) \
        __builtin_amdgcn_global_load_lds((const unsigned*)((const unsigned char*)(gbase) + (size_t)_i * p2##voff + vo##voff), (LAS unsigned*)(lds + (bufoff) + ldsw + _i * 8192), 16, 0, 0); } while (0)
#define G8_LDA(dst, b, h) do { _Pragma("unroll") for (int m = 0; m < 4; ++m) _Pragma("unroll") for (int k = 0; k < 2; ++k) dst[m][k] = *(const LAS bf16x8*)(lds + G8_SA(b, h) + aoff + m * 2048 + k * 1024); } while (0)
#define G8_LDB(dst, b, h) do { _Pragma("unroll") for (int n = 0; n < 2; ++n) _Pragma("unroll") for (int k = 0; k < 2; ++k) dst[n][k] = *(const LAS bf16x8*)(lds + G8_SB(b, h) + boff + n * 2048 + k * 1024); } while (0)
#define G8_MMA(ai, bj, At, Bt) do { __builtin_amdgcn_s_setprio(1); _Pragma("unroll") for (int m = 0; m < 4; ++m) _Pragma("unroll") for (int n = 0; n < 2; ++n) _Pragma("unroll") for (int k = 0; k < 2; ++k) \
        acc[ai][bj][m][n] = __builtin_amdgcn_mfma_f32_16x16x32_bf16(Bt[n][k], At[m][k], acc[ai][bj][m][n], 0, 0, 0); __builtin_amdgcn_s_setprio(0); } while (0)
#define G8_WAIT_V(n) asm volatile("s_waitcnt vmcnt(" #n ")" ::: "memory")
#define G8_WAIT_L(n) asm volatile("s_waitcnt lgkmcnt(" #n ")" ::: "memory")
#define G8_BAR __builtin_amdgcn_s_barrier()
#define G8_SCHED __builtin_amdgcn_sched_barrier(0)
#define G8_ZERO() do { _Pragma("unroll") for (int a = 0; a < 2; ++a) _Pragma("unroll") for (int b = 0; b < 2; ++b) _Pragma("unroll") for (int m = 0; m < 4; ++m) _Pragma("unroll") for (int n = 0; n < 2; ++n) acc[a][b][m][n] = (f32x4){0.f, 0.f, 0.f, 0.f}; } while (0)
    Leg cur, nxt; int ui = 0;
    if (!get_leg(g, 0, cur)) return;
    f32x4 acc[2][2][4][2];
    G8_ZERO();
    bf16x8 At[4][2], B0[2][2], B1[2][2];
    const unsigned char* cA = cur.A; const unsigned char* cB = cur.B;
    G8_STAGE(G8_SB(0, 0), cB, offB); G8_STAGE(G8_SB(0, 1), cB + hstepB, offB); G8_STAGE(G8_SA(0, 0), cA, offA); G8_STAGE(G8_SA(0, 1), cA + hstepA, offA);
    if (wr == 1) G8_BAR;
    G8_WAIT_V(2); G8_BAR;
    G8_STAGE(G8_SB(1, 0), cB + kstep, offB); G8_STAGE(G8_SA(1, 0), cA + kstep, offA); G8_STAGE(G8_SB(1, 1), cB + hstepB + kstep, offB);
    G8_WAIT_V(6); G8_BAR;
    for (;;) {
        const bool has_next = get_leg(g, ui + 1, nxt);
        const unsigned char* nA = has_next ? nxt.A : cA; const unsigned char* nB = has_next ? nxt.B : cB;
        const int nt = cur.nt;
        for (int t = 0; t < nt; t += 2) {
            const bool last = (t == nt - 2);
            const unsigned char* a1 = cA + (size_t)(t + 1) * kstep;
            const unsigned char* a2 = last ? nA : cA + (size_t)(t + 2) * kstep; const unsigned char* b2 = last ? nB : cB + (size_t)(t + 2) * kstep;
            const unsigned char* a3 = a2 + kstep; const unsigned char* b3 = b2 + kstep;
            G8_LDB(B0, 0, 0); G8_LDB(B1, 0, 1); G8_SCHED; G8_LDA(At, 0, 0); G8_STAGE(G8_SA(1, 1), a1 + hstepA, offA);
            G8_WAIT_V(8); G8_WAIT_L(0); G8_BAR; G8_MMA(0, 0, At, B0); G8_MMA(0, 1, At, B1); G8_BAR; G8_SCHED;
            G8_LDA(At, 0, 1); G8_STAGE(G8_SB(0, 0), b2, offB); G8_STAGE(G8_SB(0, 1), b2 + hstepB, offB); G8_STAGE(G8_SA(0, 0), a2, offA);
            G8_WAIT_V(8); G8_WAIT_L(0); G8_BAR; G8_MMA(1, 0, At, B0); G8_MMA(1, 1, At, B1); G8_BAR; G8_SCHED;
            G8_LDB(B0, 1, 0); G8_LDB(B1, 1, 1); G8_SCHED; G8_LDA(At, 1, 0); G8_STAGE(G8_SA(0, 1), a2 + hstepA, offA);
            G8_WAIT_V(8); G8_WAIT_L(0); G8_BAR; G8_MMA(0, 0, At, B0); G8_MMA(0, 1, At, B1); G8_BAR; G8_SCHED;
            G8_LDA(At, 1, 1); G8_STAGE(G8_SB(1, 0), b3, offB); G8_STAGE(G8_SB(1, 1), b3 + hstepB, offB); G8_STAGE(G8_SA(1, 0), a3, offA);
            G8_WAIT_V(8); G8_WAIT_L(0); G8_BAR; G8_MMA(1, 0, At, B0); G8_MMA(1, 1, At, B1); G8_BAR; G8_SCHED;
        }
        if (wr == 0) G8_BAR;
        E(acc, cur, wr, wc, fr, fq);
        if (!has_next) break;
        if (cur.seg == g.nseg - 1) G8_ZERO();
        cur = nxt; cA = nA; cB = nB; ++ui;
        if (wr == 1) G8_BAR;
    }
    G8_WAIT_V(0);
    G8_BAR;
#undef G8_SA
#undef G8_SB
#undef G8_STAGE
#undef G8_LDA
#undef G8_LDB
#undef G8_MMA
#undef G8_WAIT_V
#undef G8_WAIT_L
#undef G8_BAR
#undef G8_SCHED
#undef G8_ZERO
}

#define EPI_LOOP_BEGIN \
    _Pragma("unroll") for (int ai = 0; ai < 2; ++ai) _Pragma("unroll") for (int m = 0; m < 4; ++m) { const int row = l.R0 + ai * 128 + wr * 64 + m * 16 + fr; \
    _Pragma("unroll") for (int bj = 0; bj < 2; ++bj) { const int col = l.c0 + bj * 128 + wc * 32 + 8 * fq; f32x4 v0 = acc[ai][bj][m][0], v1 = acc[ai][bj][m][1];
#define EPI_LOOP_END __builtin_amdgcn_sched_barrier(0); } }

struct EpiIn {
    bf16_t* z; bf16_t* g; const float* bgate;
    __device__ __forceinline__ void operator()(f32x4 (&acc)[2][2][4][2], const Leg& l, int wr, int wc, int fr, int fq) const {
        EPI_LOOP_BEGIN
            if (l.c0 + bj * 128 < ZW) {
                u32x4 w; w.x = pk2(v0[0], v0[1]); w.y = pk2(v0[2], v0[3]); w.z = pk2(v1[0], v1[1]); w.w = pk2(v1[2], v1[3]);
                *(u32x4*)(z + (size_t)row * ZW + col) = w;
            } else {
                const int cg_ = col - ZW; const f32x4 b0 = *(const f32x4*)(bgate + cg_), b1 = *(const f32x4*)(bgate + cg_ + 4);
                u32x4 w; w.x = pk2(sigmoidf_(v0[0] + b0[0]), sigmoidf_(v0[1] + b0[1])); w.y = pk2(sigmoidf_(v0[2] + b0[2]), sigmoidf_(v0[3] + b0[3]));
                w.z = pk2(sigmoidf_(v1[0] + b1[0]), sigmoidf_(v1[1] + b1[1])); w.w = pk2(sigmoidf_(v1[2] + b1[2]), sigmoidf_(v1[3] + b1[3]));
                *(u32x4*)(g + (size_t)row * GW + cg_) = w;
            }
        EPI_LOOP_END
    }
};
struct EpiMerge {
    const bf16_t* g; bf16_t* H; int hrow0;
    __device__ __forceinline__ void operator()(f32x4 (&acc)[2][2][4][2], const Leg& l, int wr, int wc, int fr, int fq) const {
        EPI_LOOP_BEGIN
            const bf16_t* gp = g + (size_t)row * GW + col;
            const u32x4 ga = *(const u32x4*)(gp + l.seg * 1024);
            float f[8] = {bflo(ga.x), bfhi(ga.x), bflo(ga.y), bfhi(ga.y), bflo(ga.z), bfhi(ga.z), bflo(ga.w), bfhi(ga.w)};
            if (l.seg < 2) {
                const u32x4 gb = *(const u32x4*)(gp + (l.seg + 1) * 1024);
                const float d[8] = {bflo(gb.x), bfhi(gb.x), bflo(gb.y), bfhi(gb.y), bflo(gb.z), bfhi(gb.z), bflo(gb.w), bfhi(gb.w)};
#pragma unroll
                for (int e = 0; e < 8; ++e) f[e] = f[e] * __builtin_amdgcn_rcpf(d[e]);
                acc[ai][bj][m][0] = (f32x4){v0[0] * f[0], v0[1] * f[1], v0[2] * f[2], v0[3] * f[3]};
                acc[ai][bj][m][1] = (f32x4){v1[0] * f[4], v1[1] * f[5], v1[2] * f[6], v1[3] * f[7]};
            } else {
                u32x4 w; w.x = pk2(v0[0] * f[0], v0[1] * f[1]); w.y = pk2(v0[2] * f[2], v0[3] * f[3]); w.z = pk2(v1[0] * f[4], v1[1] * f[5]); w.w = pk2(v1[2] * f[6], v1[3] * f[7]);
                *(u32x4*)(H + (size_t)(hrow0 + row) * DM + col) = w;
            }
        EPI_LOOP_END
    }
};
template <bool F32SRC> struct EpiRes {
    const float* xin; const float* cin; bf16_t* S; const float* mod; int goff; float* slabs;
    __device__ __forceinline__ void operator()(f32x4 (&acc)[2][2][4][2], const Leg& l, int wr, int wc, int fr, int fq) const {
        const int hb = l.R0 / HROWS, lr = l.R0 - hb * HROWS;
        const float* src = nullptr; int modrow;
        if (lr < LROWS) { const size_t li = (size_t)hb * LROWS + lr; if (F32SRC) src = xin + li * DM; modrow = 2 * hb + (lr >> 13); }
        else { const size_t ci = (size_t)hb * 512 + (lr - LROWS); if (F32SRC) src = cin + ci * DM; modrow = 4; }
        const float* gate = mod + (size_t)modrow * 6144 + goff;
        if (l.slab >= 0) {
            float* sb = slabs + (size_t)l.slab * 65536;
            EPI_LOOP_BEGIN
                float* q = sb + (size_t)(row - l.R0) * 256 + (col - l.c0);
                *(f32x4*)q = v0; *(f32x4*)(q + 4) = v1;
            EPI_LOOP_END
            return;
        }
        EPI_LOOP_BEGIN
            bf16_t* dp = S + (size_t)row * DM + col;
            const f32x4 gv0 = *(const f32x4*)(gate + col), gv1 = *(const f32x4*)(gate + col + 4);
            f32x4 s0, s1;
            if (F32SRC) { const size_t o = (size_t)(row - l.R0) * DM + col; s0 = *(const f32x4*)(src + o); s1 = *(const f32x4*)(src + o + 4); }
            else { const u32x4 r_ = *(const u32x4*)dp; s0 = (f32x4){bflo(r_.x), bfhi(r_.x), bflo(r_.y), bfhi(r_.y)}; s1 = (f32x4){bflo(r_.z), bfhi(r_.z), bflo(r_.w), bfhi(r_.w)}; }
            const f32x4 y0 = s0 + gv0 * v0, y1 = s1 + gv1 * v1;
            u32x4 w; w.x = pk2(y0[0], y0[1]); w.y = pk2(y0[2], y0[3]); w.z = pk2(y1[0], y1[1]); w.w = pk2(y1[2], y1[3]);
            *(u32x4*)dp = w;
        EPI_LOOP_END
    }
};
struct EpiUp {
    bf16_t* a;
    __device__ __forceinline__ void operator()(f32x4 (&acc)[2][2][4][2], const Leg& l, int wr, int wc, int fr, int fq) const {
        EPI_LOOP_BEGIN
#pragma unroll
            for (int e = 0; e < 4; ++e) { const float a0 = fmaxf(v0[e], 0.f), a1 = fmaxf(v1[e], 0.f); v0[e] = a0 * a0; v1[e] = a1 * a1; }
            u32x4 w; w.x = pk2(v0[0], v0[1]); w.y = pk2(v0[2], v0[3]); w.z = pk2(v1[0], v1[1]); w.w = pk2(v1[2], v1[3]);
            *(u32x4*)(a + (size_t)row * FF + col) = w;
        EPI_LOOP_END
    }
};
}

__device__ __forceinline__ void transpose_tile(ldsp lds, const float* src, bf16_t* dst, int K, int N, int tk, int tn) {
    const int tid = tid_();
    LAS float* T = (LAS float*)lds;
#pragma unroll
    for (int i = 0; i < 2; ++i) {
        const int k = (tid >> 4) + i * 32, n4 = (tid & 15) * 4;
        const f32x4 v = *(const f32x4*)(src + (size_t)(tk * 64 + k) * N + tn * 64 + n4);
        T[k * 65 + n4] = v[0]; T[k * 65 + n4 + 1] = v[1]; T[k * 65 + n4 + 2] = v[2]; T[k * 65 + n4 + 3] = v[3];
    }
    __syncthreads();
    const int n = tid >> 3, k8 = (tid & 7) * 8;
    u32x4 w;
    w.x = pk2(T[(k8 + 0) * 65 + n], T[(k8 + 1) * 65 + n]); w.y = pk2(T[(k8 + 2) * 65 + n], T[(k8 + 3) * 65 + n]);
    w.z = pk2(T[(k8 + 4) * 65 + n], T[(k8 + 5) * 65 + n]); w.w = pk2(T[(k8 + 6) * 65 + n], T[(k8 + 7) * 65 + n]);
    *(u32x4*)(dst + (size_t)(tn * 64 + n) * K + tk * 64 + k8) = w;
    __syncthreads();
}

__device__ __forceinline__ void phase_prologue(KP p, ldsp lds) {
    const int tid = tid_(), G = gridDim.x;
    for (int it = blockIdx.x; it < 2 * 4288; it += G) {
        const int l = it / 4288; int r = it - l * 4288;
        const float* src; bf16_t* dst; int K, N;
        if (r < 1600) { src = p->w_in + (size_t)l * DM * NIN; dst = (bf16_t*)(p->ws + WS_WIN) + (size_t)l * NIN * DM; K = DM; N = NIN; }
        else if (r < 1984) { r -= 1600; const int n = r / 128; r -= n * 128; src = p->w_branch + (size_t)(l * 3 + n) * 512 * DM; dst = (bf16_t*)(p->ws + WS_WBR) + (size_t)(l * 3 + n) * DM * 512; K = 512; N = DM; }
        else if (r < 2240) { r -= 1984; src = p->w_out + (size_t)l * DM * DM; dst = (bf16_t*)(p->ws + WS_WOUT) + (size_t)l * DM * DM; K = DM; N = DM; }
        else if (r < 3264) { r -= 2240; src = p->w_up + (size_t)l * DM * FF; dst = (bf16_t*)(p->ws + WS_WUP) + (size_t)l * FF * DM; K = DM; N = FF; }
        else { r -= 3264; src = p->w_down + (size_t)l * FF * DM; dst = (bf16_t*)(p->ws + WS_WDN) + (size_t)l * DM * FF; K = FF; N = DM; }
        const int ntn = N / 64; const int tk = r / ntn, tn = r - tk * ntn;
        transpose_tile(lds, src, dst, K, N, tk, tn);
    }
    {
        LAS float* red = (LAS float*)lds;
        float* mod = (float*)(p->ws + WS_MOD);
        for (int it = blockIdx.x; it < 768; it += G) {
            const int j0 = it * 16, l = j0 / 6144, jj0 = j0 - l * 6144, jc = tid & 15, ks = tid >> 4;
            float a0 = 0.f, a1 = 0.f, a2 = 0.f, a3 = 0.f, a4 = 0.f;
            const float* wp = p->w_mod + ((size_t)l * DM + ks * 32) * 6144 + jj0 + jc;
#pragma unroll 8
            for (int i = 0; i < 32; ++i) {
                const int k = ks * 32 + i; const float w = wp[(size_t)i * 6144];
                const float c0 = p->c[k], c1 = p->c[DM + k], c2 = p->c[2 * DM + k], c3 = p->c[3 * DM + k], c4 = p->c_ctx[k];
                a0 += c0 * sigmoidf_(c0) * w; a1 += c1 * sigmoidf_(c1) * w; a2 += c2 * sigmoidf_(c2) * w; a3 += c3 * sigmoidf_(c3) * w; a4 += c4 * sigmoidf_(c4) * w;
            }
            red[(0 * 32 + ks) * 16 + jc] = a0; red[(1 * 32 + ks) * 16 + jc] = a1; red[(2 * 32 + ks) * 16 + jc] = a2; red[(3 * 32 + ks) * 16 + jc] = a3; red[(4 * 32 + ks) * 16 + jc] = a4;
            __syncthreads();
            if (tid < 80) { const int r = tid >> 4, c = tid & 15; float s = 0.f;
                for (int q = 0; q < 32; ++q) s += red[(r * 32 + q) * 16 + c];
                mod[((size_t)l * 5 + r) * 6144 + jj0 + c] = s + p->b_mod[(size_t)l * 6144 + jj0 + c]; }
            __syncthreads();
        }
    }
    {
        f32x2* cs = (f32x2*)(p->ws + WS_ROPE);
        for (int idx = blockIdx.x * 512 + tid; idx < 8192 * 32; idx += G * 512) {
            const int t = idx >> 5, e = idx & 31, axis = e >> 4, f = e & 15;
            const float pos = (float)(axis == 0 ? (t >> 6) : (t & 63));
            const float inv = powf(10000.0f, -(float)f * (1.0f / 16.0f));
            const float ang = pos * inv;
            cs[idx] = (f32x2){cosf(ang), sinf(ang)};
        }
    }
    if (blockIdx.x == 0 && tid < 128) {
        const int l = tid >> 6, e = tid & 63;
        const float s1 = wave_sum(p->lq1[l * 64 + e] * p->lk1[l * 64 + e]), s2 = wave_sum(p->lq2[l * 64 + e] * p->lk2[l * 64 + e]);
        if (e == 0) ((float*)(p->ws + WS_LAM))[l] = expf(s1) - expf(s2) + lam_init_of(l);
    }
}

__device__ __forceinline__ void phase_norm(KP p, int layer, int which) {
    const int tid = tid_(), lane = tid & 63, wv = tid >> 6;
    const float* ng = (which == 0 ? p->norm1_g : p->norm2_g) + (size_t)layer * DM;
    bf16_t* H = (bf16_t*)(p->ws + WS_H);
    const int stride = gridDim.x * 8;
    for (int R0 = blockIdx.x * 8 + wv; R0 < MROWS; R0 += 2 * stride) {
        f32x4 v[2][4]; const float* mod[2]; bool ok[2];
#pragma unroll
        for (int u = 0; u < 2; ++u) {
            const int R = R0 + u * stride; ok[u] = R < MROWS; mod[u] = nullptr;
            if (ok[u]) {
                const RowMap rm = rowmap(p, R);
                if (layer == 1 && which == 1 && rm.modrow == 4) { ok[u] = false; continue; }
                mod[u] = (const float*)(p->ws + WS_MOD) + ((size_t)layer * 5 + rm.modrow) * 6144 + (which == 0 ? 0 : 3 * DM);
                if (layer == 0 && which == 0) {
#pragma unroll
                    for (int k = 0; k < 4; ++k) v[u][k] = *(const f32x4*)(rm.src + k * 256 + lane * 4);
                } else {
                    const bf16_t* sp_ = (const bf16_t*)(p->ws + WS_XS) + (size_t)R * DM;
#pragma unroll
                    for (int k = 0; k < 4; ++k) { const u32x2 r_ = *(const u32x2*)(sp_ + k * 256 + lane * 4); v[u][k] = (f32x4){bflo(r_.x), bfhi(r_.x), bflo(r_.y), bfhi(r_.y)}; }
                }
                if (layer == 1 && which == 0 && rm.modrow == 4) {
                    const int hb_ = R / HROWS, c_ = R - hb_ * HROWS - LROWS, j_ = hb_ * 2 + (c_ >> 8), r_ = c_ & 255;
                    const float* g2 = (const float*)(p->ws + WS_MOD) + (size_t)4 * 6144 + 5 * DM;
                    const float* sb = (const float*)(p->ws + WS_KD) + (size_t)r_ * 256 + lane * 4;
#pragma unroll
                    for (int k = 0; k < 4; ++k) { f32x4 a = (f32x4){0.f, 0.f, 0.f, 0.f};
#pragma unroll
                        for (int ks = 0; ks < 8; ++ks) a += *(const f32x4*)(sb + (size_t)((j_ * 4 + k) * 8 + ks) * 65536);
                        v[u][k] += *(const f32x4*)(g2 + k * 256 + lane * 4) * a; }
                }
            }
        }
#pragma unroll
        for (int u = 0; u < 2; ++u) {
            if (!ok[u]) continue;
            const int R = R0 + u * stride;
            float ss = 0.f;
#pragma unroll
            for (int k = 0; k < 4; ++k) ss += v[u][k][0] * v[u][k][0] + v[u][k][1] * v[u][k][1] + v[u][k][2] * v[u][k][2] + v[u][k][3] * v[u][k][3];
            ss = wave_sum(ss);
            const float rstd = rsqrtf(ss * (1.0f / DM) + EPS);
#pragma unroll
            for (int k = 0; k < 4; ++k) {
                const int c = k * 256 + lane * 4;
                const f32x4 gg = *(const f32x4*)(ng + c), sh = *(const f32x4*)(mod[u] + c), sc = *(const f32x4*)(mod[u] + DM + c);
                float y[4];
#pragma unroll
                for (int e = 0; e < 4; ++e) y[e] = v[u][k][e] * rstd * gg[e] * (1.0f + sc[e]) + sh[e];
                u32x2 w; w.x = pk2(y[0], y[1]); w.y = pk2(y[2], y[3]);
                *(u32x2*)(H + (size_t)R * DM + c) = w;
            }
        }
    }
}

__device__ __forceinline__ void phase_final(KP p) {
    const int tid = tid_(), lane = tid & 63, wv = tid >> 6;
    const int stride = gridDim.x * 8;
    const bf16_t* S = (const bf16_t*)(p->ws + WS_XS);
    for (int r0 = blockIdx.x * 8 + wv; r0 < NBATCH * SEQ; r0 += 2 * stride) {
        f32x4 v[2][4];
#pragma unroll
        for (int u = 0; u < 2; ++u) { const int r = r0 + u * stride;
            if (r < NBATCH * SEQ) { const int hb = r >> 14; const bf16_t* sp_ = S + (size_t)(hb * HROWS + (r & (LROWS - 1))) * DM;
#pragma unroll
                for (int k = 0; k < 4; ++k) { const u32x2 r_ = *(const u32x2*)(sp_ + k * 256 + lane * 4); v[u][k] = (f32x4){bflo(r_.x), bfhi(r_.x), bflo(r_.y), bfhi(r_.y)}; } } }
#pragma unroll
        for (int u = 0; u < 2; ++u) { const int r = r0 + u * stride;
            if (r < NBATCH * SEQ) {
                float* row = p->out + (size_t)r * DM; float ss = 0.f;
#pragma unroll
                for (int k = 0; k < 4; ++k) ss += v[u][k][0] * v[u][k][0] + v[u][k][1] * v[u][k][1] + v[u][k][2] * v[u][k][2] + v[u][k][3] * v[u][k][3];
                ss = wave_sum(ss);
                const float rstd = rsqrtf(ss * (1.0f / DM) + EPS);
#pragma unroll
                for (int k = 0; k < 4; ++k) { const int c = k * 256 + lane * 4; const f32x4 gg = *(const f32x4*)(p->final_g + c); *(f32x4*)(row + c) = v[u][k] * rstd * gg; }
            } }
    }
}

__device__ __forceinline__ void post_item(KP p, int l, int item, ldsp lds) {
    const int tid = tid_();
    const int lr0 = item * 32;
    const bool isctx = lr0 >= LROWS;
    int bl, t0;
    if (!isctx) { bl = lr0 >> 13; t0 = lr0 & 8191; } else { const int c = lr0 - LROWS; bl = c >> 8; t0 = c & 255; }
    const int j0 = isctx ? t0 : 256 + t0;
    const int tile = j0 >> 6, kv0 = j0 & 63;
    bf16_t* z = (bf16_t*)(p->ws + WS_Z);
    const f32x2* cs = (const f32x2*)(p->ws + WS_ROPE);
    {
        const int row = (tid >> 3) & 31, g = tid & 7, sh = tid >> 8;
        const int axis = g >> 2, half = (g >> 1) & 1, f0 = (g & 1) * 8;
        bf16_t* rowp = z + (size_t)(lr0 + row) * ZW + g * 8;
        u32x4 raw[13];
#pragma unroll
        for (int it = 0; it < 13; ++it) {
            const int slot0 = 2 * it; const int colb = slot0 < 8 ? 1024 + slot0 * 64 : slot0 < 10 ? 1536 + (slot0 - 8) * 64 : slot0 < 18 ? 1792 + (slot0 - 10) * 64 : 2304 + (slot0 - 18) * 64;
            raw[it] = *(const u32x4*)(rowp + colb + sh * 64);
        }
        f32x2 cs8[8]; float gq[8], gk[8];
        if (!isctx) { const f32x2* cp = cs + (size_t)(t0 + row) * 32 + axis * 16 + f0;
#pragma unroll
            for (int e = 0; e < 8; ++e) cs8[e] = cp[e]; }
        else {
#pragma unroll
            for (int e = 0; e < 8; ++e) cs8[e] = (f32x2){1.f, 0.f}; }
#pragma unroll
        for (int e = 0; e < 8; ++e) { gq[e] = p->q_norm_g[l * 64 + g * 8 + e]; gk[e] = p->k_norm_g[l * 64 + g * 8 + e]; }
#pragma unroll
        for (int it = 0; it < 13; ++it) {
            const int slot0 = 2 * it; const int slot = slot0 + sh;
            const int colb = slot0 < 8 ? 1024 + slot0 * 64 : slot0 < 10 ? 1536 + (slot0 - 8) * 64 : slot0 < 18 ? 1792 + (slot0 - 10) * 64 : 2304 + (slot0 - 18) * 64;
            const u32x4 rw = raw[it];
            float x[8] = {bflo(rw.x), bfhi(rw.x), bflo(rw.y), bfhi(rw.y), bflo(rw.z), bfhi(rw.z), bflo(rw.w), bfhi(rw.w)};
            if (slot0 < 10) {
                float ss = 0.f;
#pragma unroll
                for (int e = 0; e < 8; ++e) ss += x[e] * x[e];
                ss += __shfl_xor(ss, 1); ss += __shfl_xor(ss, 2); ss += __shfl_xor(ss, 4);
                const float rstd = rsqrtf(ss * (1.0f / 64.0f) + EPS);
#pragma unroll
                for (int e = 0; e < 8; ++e) x[e] = x[e] * rstd * (slot0 < 8 ? gq[e] : gk[e]);
            }
            if (!isctx) {
#pragma unroll
                for (int e = 0; e < 8; ++e) {
                    const float o = __shfl_xor(x[e], 2); const f32x2 c = cs8[e];
                    x[e] = (half == 0) ? (x[e] * c[0] - o * c[1]) : (o * c[1] + x[e] * c[0]);
                }
            }
            const bool isq = (slot0 < 8) || (slot0 >= 10 && slot0 < 18);
            if (isq) {
#pragma unroll
                for (int e = 0; e < 8; ++e) x[e] *= QSCALE;
            }
            u32x4 w; w.x = pk2(x[0], x[1]); w.y = pk2(x[2], x[3]); w.z = pk2(x[4], x[5]); w.w = pk2(x[6], x[7]);
            if (isq) *(u32x4*)(rowp + colb + sh * 64) = w;
            else {
                const int kv = kv0 + row;
                unsigned char* dst = (slot0 < 10) ? p->ws + WS_KG + ((size_t)(bl * 2 + (slot - 8)) * NKT + tile) * 8192 : p->ws + WS_KD + ((size_t)(bl * 8 + (slot - 18)) * NKT + tile) * 8192;
                *(u32x4*)(dst + g * 1024 + kv * 16) = w;
            }
        }
    }
    {
        constexpr int PITCH = 1296;
        u32x4 vr[5];
#pragma unroll
        for (int i = 0; i < 5; ++i) {
            const int pc = i * 512 + tid; const int row = pc / 80, c8 = pc - row * 80;
            const int col = (c8 < 16) ? 1664 + c8 * 8 : 2816 + (c8 - 16) * 8;
            vr[i] = *(const u32x4*)(z + (size_t)(lr0 + row) * ZW + col);
        }
#pragma unroll
        for (int i = 0; i < 5; ++i) { const int pc = i * 512 + tid; const int row = pc / 80, c8 = pc - row * 80; *(LAS u32x4*)(lds + row * PITCH + c8 * 16) = vr[i]; }
        __syncthreads();
#pragma unroll
        for (int i = 0; i < 5; ++i) {
            const int task = i * 512 + tid; const int pp = task & 3, dcol = task >> 2;
            const int sl = pp >> 1, hi = pp & 1;
            unsigned short e[8];
#pragma unroll
            for (int q = 0; q < 8; ++q) { const int rr = 16 * sl + 8 * (q >> 2) + 4 * hi + (q & 3); e[q] = *(const LAS unsigned short*)(lds + rr * PITCH + dcol * 2); }
            u32x4 w; w.x = e[0] | ((unsigned)e[1] << 16); w.y = e[2] | ((unsigned)e[3] << 16); w.z = e[4] | ((unsigned)e[5] << 16); w.w = e[6] | ((unsigned)e[7] << 16);
            const int piece = (kv0 >> 3) + pp;
            unsigned char* dst; int d;
            if (dcol < 128) { const int kh = dcol >> 6; d = dcol & 63; dst = p->ws + WS_VG + ((size_t)(bl * 2 + kh) * NKT + tile) * 8192; }
            else { const int dc = dcol - 128, h = dc >> 7; d = dc & 127; dst = p->ws + WS_VD + ((size_t)(bl * 4 + h) * NKT + tile) * 16384; }
            *(u32x4*)(dst + d * 128 + ((piece ^ ((d >> 1) & 7)) * 16)) = w;
        }
        __syncthreads();
    }
}

constexpr int LRU_U = 0, LRU_W = 9216, LRU_AB = 46080, LRU_CP = 111616;
struct LruPre { u32x4 raw[4]; u32x4 gate; float st; };
struct LruItem { int nb, bl, ci, T, ts0, lrow0; };
__device__ __forceinline__ LruItem lru_decode(int item) {
    LruItem q; q.nb = item & 7; const int cidx = item >> 3; q.bl = cidx / NCH; q.ci = cidx - q.bl * NCH;
    const bool isctx = q.ci < 4; q.T = isctx ? CTX : SEQ; q.ts0 = isctx ? q.ci * 64 : (q.ci - 4) * 64;
    q.lrow0 = isctx ? LROWS + q.bl * 256 + q.ts0 : q.bl * 8192 + q.ts0; return q;
}
__device__ __forceinline__ void lru_prefetch(KP p, int item, int pass, int tid, LruPre& q) {
    const LruItem I = lru_decode(item);
    const bf16_t* z = (const bf16_t*)(p->ws + WS_Z);
    const int tok = tid >> 3, ch = I.nb * 64 + (tid & 7) * 8;
#pragma unroll
    for (int j = 0; j < 4; ++j) { const int ts = I.ts0 + tok + j - 2; u32x4 v = (u32x4){0u, 0u, 0u, 0u};
        if (ts >= 0 && ts < I.T) v = *(const u32x4*)(z + (size_t)(I.lrow0 + tok + j - 2) * ZW + ch);
        q.raw[j] = v; }
    if (pass == 2) {
        q.gate = *(const u32x4*)(z + (size_t)(I.lrow0 + tok) * ZW + 512 + ch);
        q.st = ((const float*)(p->ws + WS_ST))[(((size_t)I.bl * NCH + I.ci) * 2 + (tid >> 8)) * 512 + I.nb * 64 + (tid & 63)];
    }
}
__device__ __forceinline__ float fast_sigmoid(float v) { return __builtin_amdgcn_rcpf(1.0f + __builtin_amdgcn_exp2f(-1.4426950408889634f * v)); }

__device__ __forceinline__ void phase_lru(KP p, int l, int pass, ldsp lds, int qidx) {
    const int tid = tid_(), lane = tid & 63, wid = tid >> 6;
    constexpr int NPER = 2 * NCH;
    const int nbq = blockIdx.x & 7;
    unsigned* ctr = (unsigned*)p->ws + 3700 + qidx * 8 + nbq;
    volatile LAS int* tk = (volatile LAS int*)(lds + LDS_BYTES - 48);
    if (tid == 0) { tk[0] = (int)__hip_atomic_fetch_add(ctr, 1u, __ATOMIC_RELAXED, __HIP_MEMORY_SCOPE_AGENT); tk[1] = (int)__hip_atomic_fetch_add(ctr, 1u, __ATOMIC_RELAXED, __HIP_MEMORY_SCOPE_AGENT); }
    __syncthreads();
    int tcur = __builtin_amdgcn_readfirstlane(tk[0]), tnxt = __builtin_amdgcn_readfirstlane(tk[1]);
    __syncthreads();
    if (tcur >= NPER) return;
    int it = tcur * 8 + nbq;
    bf16_t* z = (bf16_t*)(p->ws + WS_Z);
    LruPre cur, nxt; lru_prefetch(p, it, pass, tid, cur);
    int cached_nb = -1;
    float cw[4][8], cb[8], brg = 0.f, big = 0.f, sp = 0.f;
    const int tok1 = tid >> 3, c8 = tid & 7;
    const int dir = wid >> 2, th = (wid >> 1) & 1, nt_ = wid & 1, r32 = lane & 31, hi = lane >> 5, chl = nt_ * 32 + r32;
    const int sdir = tid >> 8, ssub = (tid >> 6) & 3, sch = tid & 63;
    for (;;) {
        int tnn = NPER;
        if (tid == 0 && tnxt < NPER) tnn = (int)__hip_atomic_fetch_add(ctr, 1u, __ATOMIC_RELAXED, __HIP_MEMORY_SCOPE_AGENT);
        const LruItem I = lru_decode(it); const int nb = I.nb;
        if (cached_nb != nb) {
            for (int e = tid; e < 4 * 4096; e += 512) {
                const int mat = e >> 12, k = (e >> 6) & 63, n = e & 63; const int d_ = mat >> 1;
                const float* W = ((mat & 1) ? p->w_ig : p->w_rg) + ((((size_t)l * 2 + d_) * 8 + nb) * 64 + k) * 64 + n;
                *(LAS unsigned short*)(lds + LRU_W + (mat * 64 + n) * 144 + k * 2) = (unsigned short)(pk2(*W, 0.f) & 0xffffu);
            }
            const int ch = nb * 64 + c8 * 8;
#pragma unroll
            for (int j = 0; j < 4; ++j) { const f32x4 w0 = *(const f32x4*)(p->conv_w + ((size_t)l * 4 + j) * 512 + ch), w1 = *(const f32x4*)(p->conv_w + ((size_t)l * 4 + j) * 512 + ch + 4);
                cw[j][0] = w0[0]; cw[j][1] = w0[1]; cw[j][2] = w0[2]; cw[j][3] = w0[3]; cw[j][4] = w1[0]; cw[j][5] = w1[1]; cw[j][6] = w1[2]; cw[j][7] = w1[3]; }
            { const f32x4 b0 = *(const f32x4*)(p->conv_b + (size_t)l * 512 + ch), b1 = *(const f32x4*)(p->conv_b + (size_t)l * 512 + ch + 4);
              cb[0] = b0[0]; cb[1] = b0[1]; cb[2] = b0[2]; cb[3] = b0[3]; cb[4] = b1[0]; cb[5] = b1[1]; cb[6] = b1[2]; cb[7] = b1[3]; }
            const size_t pi = ((size_t)l * 2 + dir) * 512 + nb * 64 + chl;
            brg = p->b_rg[pi]; big = p->b_ig[pi];
            const float lamv = p->lru_lambda[pi];
            { const float xe = __expf(-lamv);
              const float ser = xe * (1.0f - xe * (0.5f - xe * ((1.0f / 3.0f) - xe * 0.25f)));
              sp = (lamv < -20.f) ? -lamv : ((xe < 0.03f) ? ser : __logf(1.0f + xe)); }
            cached_nb = nb;
        }
        if (tnxt < NPER) lru_prefetch(p, tnxt * 8 + nbq, pass, tid, nxt);
        {
            float a[8];
#pragma unroll
            for (int e = 0; e < 8; ++e) a[e] = cb[e];
#pragma unroll
            for (int j = 0; j < 4; ++j) { const u32x4 raw = cur.raw[j];
                a[0] += bflo(raw.x) * cw[j][0]; a[1] += bfhi(raw.x) * cw[j][1]; a[2] += bflo(raw.y) * cw[j][2]; a[3] += bfhi(raw.y) * cw[j][3];
                a[4] += bflo(raw.z) * cw[j][4]; a[5] += bfhi(raw.z) * cw[j][5]; a[6] += bflo(raw.w) * cw[j][6]; a[7] += bfhi(raw.w) * cw[j][7]; }
            u32x4 w; w.x = pk2(a[0], a[1]); w.y = pk2(a[2], a[3]); w.z = pk2(a[4], a[5]); w.w = pk2(a[6], a[7]);
            *(LAS u32x4*)(lds + LRU_U + tok1 * 144 + c8 * 16) = w;
        }
        __syncthreads();
        {
            f32x16 ar = {}, aig = {};
#pragma unroll
            for (int ks = 0; ks < 4; ++ks) {
                const bf16x8 a = *(const LAS bf16x8*)(lds + LRU_U + (th * 32 + r32) * 144 + (2 * ks + hi) * 16);
                const bf16x8 br = *(const LAS bf16x8*)(lds + LRU_W + ((dir * 2 + 0) * 64 + nt_ * 32 + r32) * 144 + (2 * ks + hi) * 16);
                const bf16x8 bi = *(const LAS bf16x8*)(lds + LRU_W + ((dir * 2 + 1) * 64 + nt_ * 32 + r32) * 144 + (2 * ks + hi) * 16);
                ar = __builtin_amdgcn_mfma_f32_32x32x16_bf16(a, br, ar, 0, 0, 0);
                aig = __builtin_amdgcn_mfma_f32_32x32x16_bf16(a, bi, aig, 0, 0, 0);
            }
#pragma unroll
            for (int r = 0; r < 16; ++r) {
                const int tok = th * 32 + (r & 3) + 8 * (r >> 2) + 4 * hi;
                const float rg = fast_sigmoid(ar[r] + brg), ig = fast_sigmoid(aig[r] + big);
                const float log_a = -8.0f * rg * sp;
                const float av = __builtin_amdgcn_exp2f(1.4426950408889634f * log_a);
                const float x = 2.0f * log_a;
                const float poly = -x * (1.0f + x * 0.5f * (1.0f + x * (1.0f / 3.0f) * (1.0f + x * 0.25f * (1.0f + x * 0.2f))));
                const float em = (x > -0.25f) ? poly : (1.0f - av * av);
                const float uu = bf2f(*(const LAS unsigned short*)(lds + LRU_U + tok * 144 + chl * 2));
                const float bv = __builtin_amdgcn_sqrtf(fmaxf(em, 0.f)) * (ig * uu);
                *(LAS f32x2*)(lds + LRU_AB + ((dir * 64 + tok) * 64 + chl) * 8) = (f32x2){av, bv};
            }
        }
        if (tid == 0) tk[0] = tnn;
        __syncthreads();
        const int tnn_all = __builtin_amdgcn_readfirstlane(tk[0]);
        {
            float A = 1.f, B = 0.f;
#pragma unroll
            for (int i = 0; i < 16; ++i) {
                const int tok = ssub * 16 + (sdir == 0 ? i : 15 - i);
                const f32x2 ab = *(const LAS f32x2*)(lds + LRU_AB + ((sdir * 64 + tok) * 64 + sch) * 8);
                B = ab[0] * B + ab[1]; A = ab[0] * A;
            }
            *(LAS f32x2*)(lds + LRU_CP + ((sdir * 4 + ssub) * 64 + sch) * 8) = (f32x2){A, B};
        }
        __syncthreads();
        if (pass == 1) {
            if (ssub == 0) {
                float A = 1.f, B = 0.f;
#pragma unroll
                for (int i = 0; i < 4; ++i) {
                    const int s_ = (sdir == 0) ? i : 3 - i;
                    const f32x2 cp = *(const LAS f32x2*)(lds + LRU_CP + ((sdir * 4 + s_) * 64 + sch) * 8);
                    B = cp[0] * B + cp[1]; A = cp[0] * A;
                }
                ((f32x2*)(p->ws + WS_SUM))[(((size_t)I.bl * NCH + I.ci) * 2 + sdir) * 512 + nb * 64 + sch] = (f32x2){A, B};
            }
        } else {
            {
                float h = cur.st;
#pragma unroll
                for (int i = 0; i < 3; ++i) {
                    const int s_ = (sdir == 0) ? i : 3 - i;
                    const bool before = (sdir == 0) ? (s_ < ssub) : (s_ > ssub);
                    const f32x2 cp = *(const LAS f32x2*)(lds + LRU_CP + ((sdir * 4 + s_) * 64 + sch) * 8);
                    if (before) h = cp[0] * h + cp[1];
                }
#pragma unroll
                for (int i = 0; i < 16; ++i) {
                    const int tok = ssub * 16 + (sdir == 0 ? i : 15 - i);
                    LAS f32x2* q = (LAS f32x2*)(lds + LRU_AB + ((sdir * 64 + tok) * 64 + sch) * 8);
                    const f32x2 ab = *q;
                    h = ab[0] * h + ab[1];
                    (*q)[0] = h;
                }
            }
            __syncthreads();
            {
                bf16_t* gp = z + (size_t)(I.lrow0 + tok1) * ZW + 512 + nb * 64 + c8 * 8;
                const u32x4 raw = cur.gate;
                const float gt[8] = {bflo(raw.x), bfhi(raw.x), bflo(raw.y), bfhi(raw.y), bflo(raw.z), bfhi(raw.z), bflo(raw.w), bfhi(raw.w)};
                float y[8];
#pragma unroll
                for (int e = 0; e < 8; ++e) {
                    const float hf = (*(const LAS f32x2*)(lds + LRU_AB + ((0 * 64 + tok1) * 64 + c8 * 8 + e) * 8))[0];
                    const float hb_ = (*(const LAS f32x2*)(lds + LRU_AB + ((1 * 64 + tok1) * 64 + c8 * 8 + e) * 8))[0];
                    const float v = gt[e];
                    const float inner = 0.7978845608028654f * (v + 0.044715f * v * v * v);
                    const float th_ = 1.0f - 2.0f * __builtin_amdgcn_rcpf(1.0f + __builtin_amdgcn_exp2f(2.885390081777927f * inner));
                    y[e] = (hf + hb_) * (0.5f * v * (1.0f + th_));
                }
                u32x4 w; w.x = pk2(y[0], y[1]); w.y = pk2(y[2], y[3]); w.z = pk2(y[4], y[5]); w.w = pk2(y[6], y[7]);
                *(u32x4*)gp = w;
            }
        }
        if (tnxt >= NPER) break;
        cur = nxt; it = tnxt * 8 + nbq; tnxt = tnn_all;
    }
    __syncthreads();
}

__device__ __forceinline__ void carry_item(KP p, int item, ldsp lds) {
    const int tid = tid_();
    const int bl = item >> 4, dir = (item >> 3) & 1, nb = item & 7;
    const f32x2* sum = (const f32x2*)(p->ws + WS_SUM);
    float* st = (float*)(p->ws + WS_ST);
    for (int e = tid; e < NCH * 64; e += 512) { const int ci = e >> 6, ch = e & 63;
        *(LAS f32x2*)(lds + e * 8) = sum[(((size_t)bl * NCH + ci) * 2 + dir) * 512 + nb * 64 + ch]; }
    __syncthreads();
    if (tid < 64) {
        float h = 0.f;
        for (int i = 0; i < NCH; ++i) {
            int ci;
            if (dir == 0) ci = i; else ci = (i < 4) ? 3 - i : (NCH - 1) - (i - 4);
            st[(((size_t)bl * NCH + ci) * 2 + dir) * 512 + nb * 64 + tid] = h;
            const f32x2 ab = *(const LAS f32x2*)(lds + (ci * 64 + tid) * 8);
            h = ab[0] * h + ab[1];
        }
    }
    __syncthreads();
}

template <int DV>
__device__ __forceinline__ void attn_pass(ldsp lds, const bf16x8 (&qr)[4], const unsigned char* Kt, const unsigned char* Vt, int NT, f32x16 (&o)[DV / 32], float& lsum) {
    constexpr int VB = DV * 128, NV = DV / 64, VOFF = 24576;
    const int tid = tid_(), lane = tid & 63, r32 = lane & 31, hi = lane >> 5;
    const int wid = __builtin_amdgcn_readfirstlane(tid >> 6);
    const unsigned char* ksrc = Kt + tid * 16; const unsigned char* vsrc = Vt + tid * 16;
    const ldsp kdst = lds + wid * 1024, vdst = lds + VOFF + wid * 1024;
#define ATT_LOAD(t, buf) do { __builtin_amdgcn_global_load_lds((const unsigned*)(ksrc + (size_t)(t) * 8192), (LAS unsigned*)(kdst + (buf) * 8192), 16, 0, 0); \
        _Pragma("unroll") for (int i = 0; i < NV; ++i) __builtin_amdgcn_global_load_lds((const unsigned*)(vsrc + (size_t)(t) * VB + i * 8192), (LAS unsigned*)(vdst + (buf) * VB + i * 8192), 16, 0, 0); } while (0)
    ATT_LOAD(0, 0);
    if (NT > 1) ATT_LOAD(1, 1);
    if (NT > 1) { if (DV == 64) asm volatile("s_waitcnt vmcnt(2)" ::: "memory"); else asm volatile("s_waitcnt vmcnt(3)" ::: "memory"); }
    else asm volatile("s_waitcnt vmcnt(0)" ::: "memory");
    __builtin_amdgcn_s_barrier();
    f32x16 osum = (f32x16){};
    bf16x8 ones; { const short one = (r32 == 0) ? (short)0x3F80 : (short)0; ones = (bf16x8){one, one, one, one, one, one, one, one}; }
    float mref = 0.f, lacc = 0.f;
    f32x16 negm = (f32x16){};
#pragma unroll
    for (int d = 0; d < DV / 32; ++d) o[d] = (f32x16){};
    const int kfo = hi * 1024 + r32 * 16, vfo = r32 * 128, vx = (r32 >> 1) & 7;
    constexpr float THR = 8.0f;
    const float PINF = __builtin_inff();
    int cur = 0;
    for (int t = 0; t < NT; ++t) {
        const bool more2 = (t + 2 < NT);
        { const int nb2 = (cur == 0) ? 2 : cur - 1;
          if (more2) ATT_LOAD(t + 2, nb2); }
        const ldsp kb = lds + cur * 8192 + kfo;
        bf16x8 kf[8];
#pragma unroll
        for (int d0 = 0; d0 < 4; ++d0) { kf[2 * d0] = *(const LAS bf16x8*)(kb + d0 * 2048); kf[2 * d0 + 1] = *(const LAS bf16x8*)(kb + d0 * 2048 + 512); }
        __builtin_amdgcn_sched_barrier(0);
        f32x16 p0 = __builtin_amdgcn_mfma_f32_32x32x16_bf16(kf[0], qr[0], negm, 0, 0, 0);
        f32x16 p1 = __builtin_amdgcn_mfma_f32_32x32x16_bf16(kf[1], qr[0], negm, 0, 0, 0);
#pragma unroll
        for (int d0 = 1; d0 < 4; ++d0) {
            p0 = __builtin_amdgcn_mfma_f32_32x32x16_bf16(kf[2 * d0], qr[d0], p0, 0, 0, 0);
            p1 = __builtin_amdgcn_mfma_f32_32x32x16_bf16(kf[2 * d0 + 1], qr[d0], p1, 0, 0, 0);
        }
        __builtin_amdgcn_sched_barrier(0);
        const ldsp vb = lds + VOFF + cur * VB + vfo;
        bf16x8 va[4], vc[4];
#pragma unroll
        for (int s = 0; s < 4; ++s) va[s] = *(const LAS bf16x8*)(vb + (((2 * s + hi) ^ vx) * 16));
        __builtin_amdgcn_sched_barrier(0);
        float m0 = __builtin_amdgcn_fmed3f(__builtin_amdgcn_fmed3f(p0[0], p0[1], PINF), p0[2], PINF), m1 = __builtin_amdgcn_fmed3f(__builtin_amdgcn_fmed3f(p1[0], p1[1], PINF), p1[2], PINF);
#pragma unroll
        for (int r = 3; r < 15; r += 2) {
            m0 = __builtin_amdgcn_fmed3f(__builtin_amdgcn_fmed3f(m0, p0[r], PINF), p0[r + 1], PINF);
            m1 = __builtin_amdgcn_fmed3f(__builtin_amdgcn_fmed3f(m1, p1[r], PINF), p1[r + 1], PINF);
        }
        float mx = __builtin_amdgcn_fmed3f(__builtin_amdgcn_fmed3f(m0, p0[15], PINF), __builtin_amdgcn_fmed3f(m1, p1[15], PINF), PINF);
        { auto rr = __builtin_amdgcn_permlane32_swap(__float_as_uint(mx), __float_as_uint(mx), false, false);
          mx = __builtin_amdgcn_fmed3f(__uint_as_float(rr[0]), __uint_as_float(rr[1]), PINF); }
        if (t == 0 || __any(mx > THR)) {
            const float dl = (t == 0) ? mx : fmaxf(mx, 0.f);
            const float f = (t == 0) ? 0.f : __builtin_amdgcn_exp2f(-dl);
            mref += dl; osum[0] *= f;
#pragma unroll
            for (int r = 0; r < 16; ++r) { p0[r] -= dl; p1[r] -= dl; negm[r] = -mref; }
            asm volatile("" : "+v"(negm));
#pragma unroll
            for (int d = 0; d < DV / 32; ++d)
#pragma unroll
                for (int r = 0; r < 16; ++r) o[d][r] *= f;
        }
        bf16x8 pb[4];
#pragma unroll
        for (int r = 0; r < 16; ++r) p0[r] = __builtin_amdgcn_exp2f(p0[r]);
        { u32x4 w;
          w.x = pk2(p0[0], p0[1]); w.y = pk2(p0[2], p0[3]); w.z = pk2(p0[4], p0[5]); w.w = pk2(p0[6], p0[7]); pb[0] = __builtin_bit_cast(bf16x8, w);
          w.x = pk2(p0[8], p0[9]); w.y = pk2(p0[10], p0[11]); w.z = pk2(p0[12], p0[13]); w.w = pk2(p0[14], p0[15]); pb[1] = __builtin_bit_cast(bf16x8, w); }
#pragma unroll
        for (int s = 0; s < 4; ++s) vc[s] = *(const LAS bf16x8*)(vb + 4096 + (((2 * s + hi) ^ vx) * 16));
        __builtin_amdgcn_sched_barrier(0);
#pragma unroll
        for (int s = 0; s < 2; ++s) {
            osum = __builtin_amdgcn_mfma_f32_32x32x16_bf16(ones, pb[s], osum, 0, 0, 0);
            o[0] = __builtin_amdgcn_mfma_f32_32x32x16_bf16(va[s], pb[s], o[0], 0, 0, 0);
            if (DV == 64) o[1] = __builtin_amdgcn_mfma_f32_32x32x16_bf16(vc[s], pb[s], o[1], 0, 0, 0);
        }
#pragma unroll
        for (int r = 0; r < 16; ++r) p1[r] = __builtin_amdgcn_exp2f(p1[r]);
        { u32x4 w;
          w.x = pk2(p1[0], p1[1]); w.y = pk2(p1[2], p1[3]); w.z = pk2(p1[4], p1[5]); w.w = pk2(p1[6], p1[7]); pb[2] = __builtin_bit_cast(bf16x8, w);
          w.x = pk2(p1[8], p1[9]); w.y = pk2(p1[10], p1[11]); w.z = pk2(p1[12], p1[13]); w.w = pk2(p1[14], p1[15]); pb[3] = __builtin_bit_cast(bf16x8, w); }
        if (DV == 64) {
#pragma unroll
            for (int i = 0; i < 6; ++i) { __builtin_amdgcn_sched_group_barrier(0x008, 1, 0); __builtin_amdgcn_sched_group_barrier(0x402, 4, 0); }
        } else {
#pragma unroll
            for (int i = 0; i < 4; ++i) { __builtin_amdgcn_sched_group_barrier(0x008, 1, 0); __builtin_amdgcn_sched_group_barrier(0x402, 6, 0); }
        }
        __builtin_amdgcn_sched_barrier(0);
#pragma unroll
        for (int s = 2; s < 4; ++s) {
            osum = __builtin_amdgcn_mfma_f32_32x32x16_bf16(ones, pb[s], osum, 0, 0, 0);
            o[0] = __builtin_amdgcn_mfma_f32_32x32x16_bf16(va[s], pb[s], o[0], 0, 0, 0);
            if (DV == 64) o[1] = __builtin_amdgcn_mfma_f32_32x32x16_bf16(vc[s], pb[s], o[1], 0, 0, 0);
        }
        if (DV == 128) {
#pragma unroll
            for (int d = 1; d < DV / 32; ++d) {
                if (d + 1 < DV / 32) {
#pragma unroll
                    for (int s = 0; s < 4; ++s) { const bf16x8 x = *(const LAS bf16x8*)(vb + (d + 1) * 4096 + (((2 * s + hi) ^ vx) * 16)); if (d & 1) va[s] = x; else vc[s] = x; }
                }
                __builtin_amdgcn_sched_barrier(0);
#pragma unroll
                for (int s = 0; s < 4; ++s) o[d] = __builtin_amdgcn_mfma_f32_32x32x16_bf16((d & 1) ? vc[s] : va[s], pb[s], o[d], 0, 0, 0);
                __builtin_amdgcn_sched_barrier(0);
            }
        }
        if (more2) { if (DV == 64) asm volatile("s_waitcnt vmcnt(2) lgkmcnt(0)" ::: "memory"); else asm volatile("s_waitcnt vmcnt(3) lgkmcnt(0)" ::: "memory"); }
        else asm volatile("s_waitcnt vmcnt(0) lgkmcnt(0)" ::: "memory");
        __builtin_amdgcn_s_barrier();
        cur = (cur == 2) ? 0 : cur + 1;
    }
#undef ATT_LOAD
    { const float l0 = (hi == 0) ? osum[0] : 0.f; (void)lacc;
      auto rr = __builtin_amdgcn_permlane32_swap(__float_as_uint(l0), __float_as_uint(l0), false, false); lsum = __uint_as_float(rr[0]) + __uint_as_float(rr[1]); }
}

__device__ __forceinline__ void gqa_unit(KP p, int bl, int head, int qrow0, int NT, ldsp lds) {
    const int tid = tid_(), lane = tid & 63, wid = tid >> 6, r32 = lane & 31, hi = lane >> 5;
    bf16_t* qp = (bf16_t*)(p->ws + WS_Z) + (size_t)(qrow0 + wid * 32 + r32) * ZW + 1024 + head * 64;
    bf16x8 qr[4];
#pragma unroll
    for (int d0 = 0; d0 < 4; ++d0) qr[d0] = *(const bf16x8*)(qp + d0 * 16 + hi * 8);
    const int kh = head >> 2;
    f32x16 o[2]; float ls;
    attn_pass<64>(lds, qr, p->ws + WS_KG + (size_t)(bl * 2 + kh) * NKT * 8192, p->ws + WS_VG + (size_t)(bl * 2 + kh) * NKT * 8192, NT, o, ls);
    const float inv = 1.0f / ls;
#pragma unroll
    for (int d = 0; d < 2; ++d)
#pragma unroll
        for (int g = 0; g < 4; ++g) {
            u32x2 w; w.x = pk2(o[d][4 * g] * inv, o[d][4 * g + 1] * inv); w.y = pk2(o[d][4 * g + 2] * inv, o[d][4 * g + 3] * inv);
            *(u32x2*)(qp + d * 32 + 8 * g + 4 * hi) = w;
        }
}

__device__ __forceinline__ void diff_unit(KP p, int l, int bl, int h, int qrow0, int NT, ldsp lds) {
    const int tid = tid_(), lane = tid & 63, wid = tid >> 6, r32 = lane & 31, hi = lane >> 5;
    bf16_t* qp = (bf16_t*)(p->ws + WS_Z) + (size_t)(qrow0 + wid * 32 + r32) * ZW + 1792 + h * 128;
    f32x4* stash = (f32x4*)(p->out + ((size_t)blockIdx.x * 512 + tid) * 64);
    const float lam = ((const float*)(p->ws + WS_LAM))[l];
    f32x16 o[4]; float ls;
    for (int j = 0; j < 2; ++j) {
        bf16x8 qr[4];
#pragma unroll
        for (int d0 = 0; d0 < 4; ++d0) qr[d0] = *(const bf16x8*)(qp + j * 64 + d0 * 16 + hi * 8);
        attn_pass<128>(lds, qr, p->ws + WS_KD + (size_t)(bl * 8 + 2 * h + j) * NKT * 8192, p->ws + WS_VD + (size_t)(bl * 4 + h) * NKT * 16384, NT, o, ls);
        const float inv = 1.0f / ls;
        if (j == 0) {
#pragma unroll
            for (int d = 0; d < 4; ++d)
#pragma unroll
                for (int g = 0; g < 4; ++g) stash[d * 4 + g] = (f32x4){o[d][4 * g] * inv, o[d][4 * g + 1] * inv, o[d][4 * g + 2] * inv, o[d][4 * g + 3] * inv};
        } else {
            float ss = 0.f;
#pragma unroll
            for (int d = 0; d < 4; ++d)
#pragma unroll
                for (int g = 0; g < 4; ++g) { const f32x4 s1 = stash[d * 4 + g];
#pragma unroll
                    for (int e = 0; e < 4; ++e) { const float v = s1[e] - lam * (o[d][4 * g + e] * inv); o[d][4 * g + e] = v; ss = __builtin_fmaf(v, v, ss); }
                    __builtin_amdgcn_sched_barrier(0); }
            ss += __shfl_xor(ss, 32);
            const float rstd = rsqrtf(ss * (1.0f / 128.0f) + EPS) * (1.0f - lam_init_of(l));
            const float* sg = p->subln_g + (size_t)l * 128;
#pragma unroll
            for (int d = 0; d < 4; ++d)
#pragma unroll
                for (int g = 0; g < 4; ++g) {
                    const int dd = d * 32 + 8 * g + 4 * hi;
                    const f32x4 gg = *(const f32x4*)(sg + dd);
                    u32x2 w; w.x = pk2(o[d][4 * g] * rstd * gg[0], o[d][4 * g + 1] * rstd * gg[1]); w.y = pk2(o[d][4 * g + 2] * rstd * gg[2], o[d][4 * g + 3] * rstd * gg[3]);
                    *(u32x2*)(qp + dd) = w;
                }
        }
    }
}

__device__ __forceinline__ void phase_post(KP p, int l, int hb, ldsp lds) {
    const int G = gridDim.x;
    for (int it = blockIdx.x; it < HROWS / 32; it += G) post_item(p, l, it, lds);
    phase_lru(p, l, 1, lds, (l * 2 + hb) * 2 + 0);
}
__device__ __forceinline__ void phase_carry(KP p, ldsp lds) {
    for (int it = blockIdx.x; it < 32; it += gridDim.x) carry_item(p, it, lds);
}
__device__ __forceinline__ void phase_mix(KP p, int l, int hb, ldsp lds) {
    const int G = gridDim.x;
    const int nctx = (l == 0) ? 24 : 0;
    const int total = 256 + 512 + nctx;
    int b0_ = blockIdx.x; asm volatile("" : "+s"(b0_));
    for (int it = b0_; it < total; it += G) {
        int isdiff, bl, head, qrow0, NT = NKT;
        if (it < 256) { const int combo = it & 7, qb = it >> 3; isdiff = 1; bl = combo >> 2; head = combo & 3; qrow0 = bl * 8192 + qb * 256; }
        else if (it < 768) { const int u = it - 256; const int combo = u & 15, qb = u >> 4; isdiff = 0; bl = combo >> 3; head = combo & 7; qrow0 = bl * 8192 + qb * 256; }
        else { const int u = it - 768; NT = 4;
            if (u < 8) { isdiff = 1; bl = u >> 2; head = u & 3; } else { const int v = u - 8; isdiff = 0; bl = v >> 3; head = v & 7; }
            qrow0 = LROWS + bl * 256; }
        if (isdiff) diff_unit(p, l, bl, head, qrow0, NT, lds); else gqa_unit(p, bl, head, qrow0, NT, lds);
    }
    phase_lru(p, l, 2, lds, (l * 2 + hb) * 2 + 1);
}

#define XB_TMO      128
#define XB_XCNT(j)  (256  + 64 * (j))
#define XB_XSUB(j)  (1280 + 64 * (j))
#define XB_XGEN(j)  (2304 + 64 * (j))
#define XB_TOP      3328
#define XB_TOPGEN   3392
#define XCD_BAR_WORDS 3456
#define XB_SPIN_CAP (1u << 18)

__device__ __forceinline__ unsigned xb_ld(unsigned* p)              { return __hip_atomic_load(p, __ATOMIC_RELAXED, __HIP_MEMORY_SCOPE_AGENT); }
__device__ __forceinline__ unsigned xb_add(unsigned* p, unsigned v) { return __hip_atomic_fetch_add(p, v, __ATOMIC_RELAXED, __HIP_MEMORY_SCOPE_AGENT); }
__device__ __forceinline__ unsigned xb_xcc_id() { return (unsigned)__builtin_amdgcn_s_getreg((3 << 11) | 20) & 0xFu; }
#define XB_SPIN(cond, bar) do { unsigned _sp = 0; while (cond) { __builtin_amdgcn_s_sleep(1); \
    if ((++_sp & 255u) == 0u) { if (xb_ld(&(bar)[XB_TMO])) break; if (_sp > XB_SPIN_CAP) { atomicAdd(&(bar)[XB_TMO], 1u); break; } } } } while (0)

struct XcdBarrier {
    unsigned* bar; unsigned x;
    volatile LAS unsigned* st;
};

__device__ __forceinline__ XcdBarrier xcd_barrier_post(unsigned* bar, volatile LAS unsigned* st) {
    XcdBarrier b; b.bar = bar; b.x = xb_xcc_id(); b.st = st;
    if (threadIdx.x == 0) (void)xb_add(&bar[XB_XCNT(b.x)], 1u);
    return b;
}
__device__ __forceinline__ void xcd_barrier_complete(unsigned* bar, unsigned x, unsigned& nloc, unsigned& nx) {
    const unsigned G = gridDim.x * gridDim.y * gridDim.z;
    unsigned sum, cnt, mine, sp = 0u;
    for (;;) {
        sum = 0u; cnt = 0u; mine = 0u;
#pragma unroll
        for (unsigned j = 0; j < 16; ++j) { const unsigned c = xb_ld(&bar[XB_XCNT(j)]); sum += c; cnt += (c > 0u) ? 1u : 0u; mine = (j == x) ? c : mine; }
        if (sum == G) break;
        __builtin_amdgcn_s_sleep(1);
        if ((++sp & 255u) == 0u) { if (xb_ld(&bar[XB_TMO])) break; if (sp > XB_SPIN_CAP) { atomicAdd(&bar[XB_TMO], 1u); break; } }
    }
    nloc = mine > 0u ? mine : 1u; nx = cnt > 0u ? cnt : 1u;
}

__device__ __forceinline__ void xcd_barrier(const XcdBarrier& b) {
    asm volatile("s_waitcnt vmcnt(0)" ::: "memory");
    __syncthreads();
    if (threadIdx.x == 0) {
        unsigned* bar = b.bar; const unsigned bx = xb_xcc_id();
        __builtin_amdgcn_s_waitcnt(0);
        unsigned nloc = b.st[0], nx = b.st[1];
        if (nloc == 0u) { xcd_barrier_complete(bar, bx, nloc, nx); b.st[0] = nloc; b.st[1] = nx; }
        const unsigned old = xb_add(&bar[XB_XSUB(bx)], 1u);
        const unsigned gen = old / nloc;
        if (old + 1u == (gen + 1u) * nloc) {
            __builtin_amdgcn_fence(__ATOMIC_RELEASE, "agent");
            asm volatile("s_waitcnt vmcnt(0)" ::: "memory");
            const unsigned og = xb_add(&bar[XB_TOP], 1u);
            const unsigned tg = og / nx;
            if (og + 1u == (tg + 1u) * nx) xb_add(&bar[XB_TOPGEN], 1u);
            else XB_SPIN(xb_ld(&bar[XB_TOPGEN]) == tg, bar);
            __builtin_amdgcn_fence(__ATOMIC_ACQUIRE, "agent");
            xb_add(&bar[XB_XGEN(bx)], 1u);
            asm volatile("s_waitcnt vmcnt(0)" ::: "memory");
        } else {
            XB_SPIN(xb_ld(&bar[XB_XGEN(bx)]) == gen, bar);
            __builtin_amdgcn_fence(__ATOMIC_ACQUIRE, "agent");
            asm volatile("s_waitcnt vmcnt(0)" ::: "memory");
        }
    }
    __syncthreads();
}

constexpr int N_PHASES = 32;
__device__ __forceinline__ void run_phase(KP p, int ph, ldsp lds) {
    unsigned char* ws = p->ws;
    if (ph == N_PHASES - 1) { phase_final(p); return; }
    const int q = ph - 1, l = q / 15, s = q - l * 15;
    if (s == 0) { phase_norm(p, l, 0); return; }
    if (s == 12) { phase_norm(p, l, 1); return; }
    if (s >= 1 && s <= 10) {
        const int hb = (s - 1) / 5, k = (s - 1) - hb * 5;
        if (k == 0) {
            g8::Desc g{}; g.A0 = ws + WS_H + (size_t)hb * HROWS * DM * 2; g.B0 = ws + WS_WIN + (size_t)l * NIN * DM * 2; g.lda = DM; g.ldb = DM; g.nt = DM / 64; g.nseg = 1; g.nM = HROWS / 256; g.nN = NIN / 256; g.skipctx = 0;
            g8::EpiIn E{(bf16_t*)(ws + WS_Z), (bf16_t*)(ws + WS_G), p->b_gate + (size_t)l * GW};
            g8::gemm_phase(lds, g, E);
        } else if (k == 1) phase_post(p, l, hb, lds);
        else if (k == 2) phase_carry(p, lds);
        else if (k == 3) phase_mix(p, l, hb, lds);
        else {
            g8::Desc g{}; const unsigned char* zb = ws + WS_Z;
            g.A0 = zb + 512 * 2; g.dA = 512 * 2; g.dA2 = 256 * 2;
            g.B0 = ws + WS_WBR + (size_t)(l * 3) * DM * 512 * 2; g.dB = DM * 512 * 2;
            g.lda = ZW; g.ldb = 512; g.nt = 8; g.nseg = 3; g.nM = (l == 0) ? 66 : 64; g.nN = 4; g.skipctx = 0;
            g8::EpiMerge E{(const bf16_t*)(ws + WS_G), (bf16_t*)(ws + WS_H), hb * HROWS};
            g8::gemm_phase(lds, g, E);
        }
        return;
    }
    g8::Desc g{}; g.nseg = 1; g.nM = (l == 0) ? 132 : 128; g.skipctx = (l == 0) ? 0 : 1;
    if (s == 11) {
        g.A0 = ws + WS_H; g.B0 = ws + WS_WOUT + (size_t)l * DM * DM * 2; g.lda = DM; g.ldb = DM; g.nt = DM / 64; g.nN = 4;
        const float* modl = (const float*)(ws + WS_MOD) + (size_t)l * 5 * 6144;
        if (l == 0) { g8::EpiRes<true> E{p->x, p->ctx, (bf16_t*)(ws + WS_XS), modl, 2 * DM, nullptr}; g8::gemm_phase(lds, g, E); }
        else { g8::EpiRes<false> E{nullptr, nullptr, (bf16_t*)(ws + WS_XS), modl, 2 * DM, nullptr}; g8::gemm_phase(lds, g, E); }
    } else if (s == 13) {
        g.A0 = ws + WS_H; g.B0 = ws + WS_WUP + (size_t)l * FF * DM * 2; g.lda = DM; g.ldb = DM; g.nt = DM / 64; g.nN = FF / 256;
        g8::EpiUp E{(bf16_t*)(ws + WS_Z)};
        g8::gemm_phase(lds, g, E);
    } else {
        g.A0 = ws + WS_Z; g.B0 = ws + WS_WDN + (size_t)l * DM * FF * 2; g.lda = FF; g.ldb = FF; g.nt = FF / 64; g.nN = 4;
        const float* modl = (const float*)(ws + WS_MOD) + (size_t)l * 5 * 6144;
        if (l == 0) { g.nM = 128; g.skipctx = 1; g.xsplit = 8; }
        g8::EpiRes<false> E{nullptr, nullptr, (bf16_t*)(ws + WS_XS), modl, 5 * DM, (float*)(ws + WS_KD)};
        g8::gemm_phase(lds, g, E);
    }
}

__global__ void __launch_bounds__(512, 2) __attribute__((amdgpu_waves_per_eu(2, 2))) mega(Params pk, int ph_lo, int ph_hi) {
    extern __shared__ __attribute__((aligned(16))) unsigned char smem[];
    const ldsp lds = (ldsp)smem;
    volatile LAS unsigned* bst = (volatile LAS unsigned*)(lds + LDS_BYTES - 16);
    if (threadIdx.x < 2) bst[threadIdx.x] = 0u;
    __syncthreads();
    XcdBarrier bar; bar.bar = (unsigned*)pk.ws; bar.x = 0; bar.st = bst;
    if (ph_hi - ph_lo > 1) bar = xcd_barrier_post((unsigned*)pk.ws, bst);
    int ph0 = ph_lo;
    if (ph_lo == 0) {
        KP p = (KP)__builtin_amdgcn_kernarg_segment_ptr();
        asm volatile("" : "+s"(p));
        phase_prologue(p, lds);
        if (ph_hi > 1) cg::this_grid().sync();
        ph0 = 1;
    }
    for (int ph = ph0; ph < ph_hi; ++ph) {
        KP p = (KP)__builtin_amdgcn_kernarg_segment_ptr();
        asm volatile("" : "+s"(p));
        run_phase(p, ph, lds);
        if (ph + 1 < ph_hi) xcd_barrier(bar);
    }
}

extern "C" void kernel_launch(void* const* d_in, const int* in_sizes, int n_in, void* d_out, int out_size, void* d_ws, size_t ws_size, hipStream_t stream) {
    static int grid = 0;
    if (grid == 0) {
        if (ws_size < WS_END) { fprintf(stderr, "kernel_launch: workspace too small: %zu < %zu\n", ws_size, (size_t)WS_END); grid = -1; return; }
        int dev = 0, cus = 0, per_cu = 0;
        hipGetDevice(&dev); hipDeviceGetAttribute(&cus, hipDeviceAttributeMultiprocessorCount, dev);
        if (hipFuncSetAttribute((const void*)mega, hipFuncAttributeMaxDynamicSharedMemorySize, LDS_BYTES) != hipSuccess) { fprintf(stderr, "kernel_launch: hipFuncSetAttribute failed\n"); grid = -1; return; }
        if (hipOccupancyMaxActiveBlocksPerMultiprocessor(&per_cu, (const void*)mega, 512, LDS_BYTES) != hipSuccess || per_cu < 1) { fprintf(stderr, "kernel_launch: occupancy query gave %d\n", per_cu); per_cu = 1; }
        (void)hipGetLastError();
        grid = cus * 1;
        if (grid > 256) grid = 256;
    }
    if (grid < 0) return;
    Params hp{};
    const float** f = (const float**)&hp;
    for (int i = 0; i < 29; ++i) f[i] = (const float*)d_in[i];
    hp.out = (float*)d_out; hp.ws = (unsigned char*)d_ws;
    if (hipMemsetAsync((char*)d_ws + WS_BAR, 0, WS_BAR_BYTES, stream) != hipSuccess) { fprintf(stderr, "kernel_launch: memset of the barrier words failed\n"); return; }
#if N_LAUNCH_MODE == 1
    int lo = 0, hi = N_PHASES;
    void* args[] = {&hp, &lo, &hi};
    hipError_t e = hipLaunchCooperativeKernel((const void*)mega, dim3(grid), dim3(512), args, LDS_BYTES, stream);
    if (e != hipSuccess) fprintf(stderr, "cooperative launch failed: %s (grid %d)\n", hipGetErrorString(e), grid);
#else
    for (int ph = 0; ph < N_PHASES; ++ph) mega<<<dim3(grid), dim3(512), LDS_BYTES, stream>>>(hp, ph, ph + 1);
#endif
}
```
